# Optimizing an MI355X kernel written in HIP

```python
import jax, jax.numpy as jnp
from jax import lax
import numpy as np

D_MODEL = 2048
BATCH = 16
SEQ = 2048
DEPTH = 4

GLA_HEADS = 4
GLA_DK = D_MODEL // 2
GLA_DV = D_MODEL
GLA_HEAD_K = GLA_DK // GLA_HEADS
GLA_HEAD_V = GLA_DV // GLA_HEADS
GLA_GATE_RANK = 16
GLA_GATE_NORMALIZER = 16.0
GLA_CHUNK = 64
GLA_SUBCHUNK = 16
GLA_SPLITS = (GLA_DK, 2 * GLA_DK, 2 * GLA_DK + GLA_DV, 2 * GLA_DK + 2 * GLA_DV)
GLA_IN = 2 * GLA_DK + 2 * GLA_DV + GLA_GATE_RANK

DIL_PATTERNS = ((128, 1), (512, 4), (2048, 16))
DIL_GROUPS = len(DIL_PATTERNS)
DIL_HEADS = 8
DIL_HEAD_DIM = 128
DIL_WIDTH = DIL_HEADS * DIL_HEAD_DIM
DIL_BLOCK = 128
DIL_IN = 3 * DIL_GROUPS * DIL_WIDTH

D_FF = 5504
CONV_WIDTH = 3

N_GLA_LAYERS = (DEPTH + 1) // 2
N_DIL_LAYERS = DEPTH // 2

DEEPNORM_ALPHA = (2 * DEPTH) ** 0.25
DEEPNORM_BETA = (8 * DEPTH) ** -0.25
LN_EPS = 1e-5
RMS_EPS = 1e-6

kernel_name = "hybrid_gla_dilated_convffn_deepnorm"


def layer_norm(x, g, b):
    xf = x.astype(jnp.float32)
    mu = xf.mean(-1, keepdims=True)
    var = jnp.square(xf - mu).mean(-1, keepdims=True)
    return ((xf - mu) * lax.rsqrt(var + LN_EPS)).astype(x.dtype) * g + b


def gla_chunk_step(state, inp):
    q, k, v, g = inp
    Bb, H, C, dk = q.shape
    c = GLA_SUBCHUNK
    n = C // c
    b = jnp.cumsum(g, axis=2)
    b_last = b[:, :, -1:, :]
    o_inter = jnp.einsum('bhcd,bhde->bhce', q * jnp.exp(b), state)
    qs = q.reshape(Bb, H, n, c, dk)
    ks = k.reshape(Bb, H, n, c, dk)
    vs = v.reshape(Bb, H, n, c, -1)
    bs = b.reshape(Bb, H, n, c, dk)
    b_ref = jnp.concatenate([jnp.zeros_like(bs[:, :, :1, -1]), bs[:, :, :-1, -1]], axis=2)
    q_ref = qs * jnp.exp(bs - b_ref[:, :, :, None, :])
    earlier = jnp.arange(C)[None, :] < (jnp.arange(n) * c)[:, None]
    k_exp = jnp.where(earlier[None, None, :, :, None],
                      b_ref[:, :, :, None, :] - b[:, :, None, :, :], -jnp.inf)
    k_ref = k[:, :, None] * jnp.exp(k_exp)
    a_inter = jnp.einsum('bhsid,bhsjd->bhsij', q_ref, k_ref)
    causal = jnp.tril(jnp.ones((c, c), dtype=bool))
    d_exp = jnp.where(causal[:, :, None],
                      bs[:, :, :, :, None, :] - bs[:, :, :, None, :, :], -jnp.inf)
    a_intra = jnp.einsum('bhsid,bhsjd,bhsijd->bhsij', qs, ks, jnp.exp(d_exp))
    o_intra = (jnp.einsum('bhsij,bhje->bhsie', a_inter, v)
               + jnp.einsum('bhsij,bhsje->bhsie', a_intra, vs)).reshape(Bb, H, C, -1)
    new_state = (jnp.exp(b_last[:, :, 0, :])[..., None] * state
                 + jnp.einsum('bhcd,bhce->bhde', k * jnp.exp(b_last - b), v))
    return new_state, o_inter + o_intra


def gla_mixer(x, w_in, w_gate_up, gate_bias, norm_g, w_out):
    B, S, _ = x.shape
    H, dk, dv, C = GLA_HEADS, GLA_HEAD_K, GLA_HEAD_V, GLA_CHUNK
    proj = x @ w_in
    q, k, v, r, g_low = jnp.split(proj, list(GLA_SPLITS), axis=-1)
    log_gate = jax.nn.log_sigmoid((g_low @ w_gate_up + gate_bias).astype(jnp.float32)) / GLA_GATE_NORMALIZER
    q = q.astype(jnp.float32) * dk ** -0.5

    def to_chunks(t, d):
        return t.astype(jnp.float32).reshape(B, S // C, C, H, d).transpose(1, 0, 3, 2, 4)

    xs = (to_chunks(q, dk), to_chunks(k, dk), to_chunks(v, dv), to_chunks(log_gate, dk))
    state0 = jnp.zeros((B, H, dk, dv), jnp.float32)
    _, o = lax.scan(gla_chunk_step, state0, xs)
    o = o.transpose(1, 0, 3, 2, 4).reshape(B, S, H, dv)
    o = o * lax.rsqrt(jnp.mean(jnp.square(o), -1, keepdims=True) + RMS_EPS) * norm_g
    o = o.reshape(B, S, GLA_DV).astype(x.dtype) * jax.nn.silu(r)
    return o @ w_out


def banded_attention(q, k, v, steps):
    N, L, H, dh = q.shape
    P = DIL_BLOCK
    nb = -(-L // P)
    Lp = nb * P
    pad = ((0, 0), (0, Lp - L), (0, 0), (0, 0))
    q, k, v = (jnp.pad(t, pad).reshape(N, nb, P, H, dh) for t in (q, k, v))

    def with_prev(t):
        prev = jnp.concatenate([jnp.zeros_like(t[:, :1]), t[:, :-1]], axis=1)
        return jnp.concatenate([prev, t], axis=2)

    kw, vw = with_prev(k), with_prev(v)
    s = jnp.einsum('nbqhd,nbkhd->nbhqk', q, kw).astype(jnp.float32) * dh ** -0.5
    qi = jnp.arange(P)[:, None] + P
    kj = jnp.arange(2 * P)[None, :]
    dist = qi - kj
    band = (dist >= 0) & (dist <= steps)
    real_key = (jnp.arange(nb)[:, None, None] > 0) | (kj[None] >= P)
    mask = band[None] & real_key
    s = jnp.where(mask[None, :, None], s, -jnp.inf)
    m = s.max(-1, keepdims=True)
    p = jnp.exp(s - m)
    l = p.sum(-1, keepdims=True)
    o = jnp.einsum('nbhqk,nbkhd->nbqhd', (p / l).astype(v.dtype), vw)
    lse = (m + jnp.log(l))[..., 0]
    o = o.reshape(N, Lp, H, dh)[:, :L]
    lse = lse.transpose(0, 1, 3, 2).reshape(N, Lp, H)[:, :L]
    return o, lse


def dilated_group(q, k, v, window, dilation):
    B, S, H, dh = q.shape
    L = S // dilation

    def to_strided(t):
        return t.reshape(B, L, dilation, H, dh).transpose(0, 2, 1, 3, 4).reshape(B * dilation, L, H, dh)

    o, lse = banded_attention(to_strided(q), to_strided(k), to_strided(v), window // dilation)
    o = o.reshape(B, dilation, L, H, dh).transpose(0, 2, 1, 3, 4).reshape(B, S, H, dh)
    lse = lse.reshape(B, dilation, L, H).transpose(0, 2, 1, 3).reshape(B, S, H)
    return o, lse


def dilated_mixer(x, w_in, w_out):
    B, S, _ = x.shape
    proj = (x @ w_in).reshape(B, S, DIL_GROUPS, 3, DIL_HEADS, DIL_HEAD_DIM)
    outs, lses = [], []
    for gi, (window, dilation) in enumerate(DIL_PATTERNS):
        o, lse = dilated_group(proj[:, :, gi, 0], proj[:, :, gi, 1], proj[:, :, gi, 2], window, dilation)
        outs.append(o)
        lses.append(lse)
    wts = jax.nn.softmax(jnp.stack(lses, 0), axis=0)
    o = jnp.einsum('gbsh,gbshd->bshd', wts.astype(x.dtype), jnp.stack(outs, 0))
    return o.reshape(B, S, DIL_WIDTH) @ w_out


def conv_ffn(x, w_up, conv_w, conv_b, w_down):
    S = x.shape[1]
    h = x @ w_up
    hp = jnp.pad(h, ((0, 0), (CONV_WIDTH - 1, 0), (0, 0)))
    h = sum((conv_w[j] * hp[:, j:j + S] for j in range(CONV_WIDTH)), conv_b)
    gate, up = jnp.split(h, 2, axis=-1)
    return (jax.nn.silu(gate) * up) @ w_down


def setup_inputs(seed: int = 0) -> dict:
    key = jax.random.key(seed)
    ks = jax.random.split(key, 16)
    nrm = lambda k, shape, scale: jax.random.normal(k, shape, jnp.float32) * scale
    return {
        "x": nrm(ks[0], (BATCH, SEQ, D_MODEL), 1.0),
        "gla_w_in": nrm(ks[1], (N_GLA_LAYERS, D_MODEL, GLA_IN), D_MODEL ** -0.5),
        "gla_w_gate_up": nrm(ks[2], (N_GLA_LAYERS, GLA_GATE_RANK, GLA_DK), GLA_GATE_RANK ** -0.5),
        "gla_gate_bias": nrm(ks[3], (N_GLA_LAYERS, GLA_DK), 0.1),
        "gla_norm_g": 1.0 + nrm(ks[4], (N_GLA_LAYERS, GLA_HEAD_V), 0.02),
        "gla_w_out": nrm(ks[5], (N_GLA_LAYERS, GLA_DV, D_MODEL), GLA_DV ** -0.5 * DEEPNORM_BETA),
        "dil_w_in": nrm(ks[6], (N_DIL_LAYERS, D_MODEL, DIL_IN), D_MODEL ** -0.5),
        "dil_w_out": nrm(ks[7], (N_DIL_LAYERS, DIL_WIDTH, D_MODEL), DIL_WIDTH ** -0.5 * DEEPNORM_BETA),
        "ffn_w_up": nrm(ks[8], (DEPTH, D_MODEL, 2 * D_FF), D_MODEL ** -0.5),
        "ffn_conv_w": nrm(ks[9], (DEPTH, CONV_WIDTH, 2 * D_FF), CONV_WIDTH ** -0.5),
        "ffn_conv_b": nrm(ks[10], (DEPTH, 2 * D_FF), 0.02),
        "ffn_w_down": nrm(ks[11], (DEPTH, D_FF, D_MODEL), D_FF ** -0.5 * DEEPNORM_BETA),
        "ln_g": 1.0 + nrm(ks[12], (DEPTH, 2, D_MODEL), 0.02),
        "ln_b": nrm(ks[13], (DEPTH, 2, D_MODEL), 0.02),
    }


def reference(x, gla_w_in, gla_w_gate_up, gla_gate_bias, gla_norm_g, gla_w_out,
              dil_w_in, dil_w_out, ffn_w_up, ffn_conv_w, ffn_conv_b, ffn_w_down, ln_g, ln_b):
    for i in range(DEPTH):
        j = i // 2
        if i % 2 == 0:
            mix = gla_mixer(x, gla_w_in[j], gla_w_gate_up[j], gla_gate_bias[j], gla_norm_g[j], gla_w_out[j])
        else:
            mix = dilated_mixer(x, dil_w_in[j], dil_w_out[j])
        x = layer_norm(DEEPNORM_ALPHA * x + mix, ln_g[i, 0], ln_b[i, 0])
        ffn = conv_ffn(x, ffn_w_up[i], ffn_conv_w[i], ffn_conv_b[i], ffn_w_down[i])
        x = layer_norm(DEEPNORM_ALPHA * x + ffn, ln_g[i, 1], ln_b[i, 1])
    return x
```

```cpp
#include <hip/hip_runtime.h>
#include <cstdio>
#include <cstdint>
#include <cstring>

__device__ __forceinline__ int fresh_tid(int wv) { int t; asm volatile("v_mbcnt_lo_u32_b32 %0, -1, 0\n\tv_mbcnt_hi_u32_b32 %0, -1, %0" : "=v"(t)); t += wv * 64; asm volatile("" : "+v"(t)); return t; }

__device__ __forceinline__ unsigned h2_pack(float lo, float hi) { const _Float16 a = (_Float16)lo, b = (_Float16)hi; return (unsigned)__builtin_bit_cast(unsigned short, a) | ((unsigned)__builtin_bit_cast(unsigned short, b) << 16); }
__device__ __forceinline__ float h_lo(unsigned w) { return (float)__builtin_bit_cast(_Float16, (unsigned short)(w & 0xffffu)); }
__device__ __forceinline__ float h_hi(unsigned w) { return (float)__builtin_bit_cast(_Float16, (unsigned short)(w >> 16)); }

namespace pg8 {
#define PG8_LAS __attribute__((address_space(3)))
typedef unsigned short bf16_t;
typedef short bf16x8 __attribute__((ext_vector_type(8)));
typedef float f32x4 __attribute__((ext_vector_type(4)));
typedef unsigned u32x4 __attribute__((ext_vector_type(4)));
typedef unsigned u32x2 __attribute__((ext_vector_type(2)));
constexpr int BM = 256, BK = 64, HALF = 128, HTB = HALF * BK * 2, STAGE_BYTES = 8 * HTB, NXCD = 8, WGM = 8;

__host__ __device__ __forceinline__ int lds_byte(int r, int c) { const int st = (r >> 4) * 2 + (c >> 5), rr = r & 15, cc = c & 31, ob = rr * 64 + cc * 2; return st * 1024 + (ob ^ (((ob >> 9) & 1) << 5)); }
__host__ __device__ __forceinline__ void stage_rc(int b, int& R, int& C) { const int st = b / 1024, sb = b % 1024, swz = sb ^ (((sb >> 9) & 1) << 5); R = (st >> 1) * 16 + swz / 64; C = (st & 1) * 32 + (swz % 64) / 2; }
__host__ __device__ __forceinline__ int perm32(int rho) { const int n = rho >> 4, i = rho & 15; return 8 * (i >> 2) + 4 * n + (i & 3); }

struct Unit { int pm, pn; };
struct Gemm { const bf16_t* A; const bf16_t* Bt; int M, N, K, lda, ldb, pad; };

struct StaticOrder {
    int nM, nN, nwg, G, c;
    __host__ __device__ void init(int M, int N, int G_, int c_) { nM = M / BM; nN = N / BM; nwg = nM * nN; G = G_; c = c_; }
    __host__ __device__ bool next(int i, Unit& u) const {
        const long L = (long)i * G + c; if (L >= nwg) return false;
        int wgid = (int)L; { const int q = nwg / NXCD, r = nwg % NXCD, xcd = wgid % NXCD, off = wgid / NXCD; wgid = (xcd < r ? xcd * (q + 1) : r * (q + 1) + (xcd - r) * q) + off; }
        const int nig = WGM * nN, gid = wgid / nig, fm = gid * WGM, gsz = (nM - fm) < WGM ? (nM - fm) : WGM;
        u.pm = fm + ((wgid % nig) % gsz); u.pn = (wgid % nig) / gsz; return true;
    }
    __device__ __forceinline__ void a_ready(const Unit&) const {}
    __device__ __forceinline__ void done(const Unit&) const {}
};

__device__ __forceinline__ unsigned cvt_pk_bf16(float lo, float hi) { unsigned r; asm volatile("v_cvt_pk_bf16_f32 %0, %1, %2" : "=v"(r) : "v"(lo), "v"(hi)); return r; }

struct EpiBf16Plain {
    static constexpr bool PERM = true, AFTER_DRAIN = false, NEEDS_LDS = false;
    bf16_t* O; int ldc; int pad;
    __device__ __forceinline__ void operator()(f32x4 (&acc)[2][2][4][2], const Unit& u, int wr, int wc, int fr, int fq) const {
        const int row0 = u.pm * BM + wr * 64 + fr, col0 = u.pn * BM + wc * 32 + 8 * fq;
#pragma unroll
        for (int ai = 0; ai < 2; ++ai)
#pragma unroll
            for (int m = 0; m < 4; ++m) { bf16_t* rowp = O + (size_t)(row0 + ai * HALF + m * 16) * ldc + col0;
#pragma unroll
                for (int bj = 0; bj < 2; ++bj) { const f32x4 v0 = acc[ai][bj][m][0], v1 = acc[ai][bj][m][1];
                    u32x4 w; w.x = cvt_pk_bf16(v0[0], v0[1]); w.y = cvt_pk_bf16(v0[2], v0[3]); w.z = cvt_pk_bf16(v1[0], v1[1]); w.w = cvt_pk_bf16(v1[2], v1[3]);
                    __builtin_nontemporal_store(w, (u32x4*)(rowp + bj * HALF)); } }
    }
};
struct EpiGlaIn {
    static constexpr bool PERM = true, AFTER_DRAIN = false, NEEDS_LDS = false;
    bf16_t* QK; float* GLOW; size_t seg;
    __device__ __forceinline__ void operator()(f32x4 (&acc)[2][2][4][2], const Unit& u, int wr, int wc, int fr, int fq) const {
        const int row0 = u.pm * BM + wr * 64 + fr;
        if (u.pn < 24) {
            bf16_t* base = QK + (size_t)(u.pn >> 3) * seg;
            const int col0 = (u.pn & 7) * BM + wc * 32 + 8 * fq;
#pragma unroll
            for (int ai = 0; ai < 2; ++ai)
#pragma unroll
                for (int m = 0; m < 4; ++m) { bf16_t* rowp = base + (size_t)(row0 + ai * HALF + m * 16) * 2048 + col0;
#pragma unroll
                    for (int bj = 0; bj < 2; ++bj) { const f32x4 v0 = acc[ai][bj][m][0], v1 = acc[ai][bj][m][1];
                        u32x4 w; w.x = cvt_pk_bf16(v0[0], v0[1]); w.y = cvt_pk_bf16(v0[2], v0[3]); w.z = cvt_pk_bf16(v1[0], v1[1]); w.w = cvt_pk_bf16(v1[2], v1[3]);
                        __builtin_nontemporal_store(w, (u32x4*)(rowp + bj * HALF)); } }
        } else if (wc == 0 && fq < 2) {
#pragma unroll
            for (int ai = 0; ai < 2; ++ai)
#pragma unroll
                for (int m = 0; m < 4; ++m) { float* rowp = GLOW + (size_t)(row0 + ai * HALF + m * 16) * 16 + 8 * fq;
                    *(f32x4*)(rowp) = acc[ai][0][m][0]; *(f32x4*)(rowp + 4) = acc[ai][0][m][1]; }
        }
    }
};
struct EpiRes {
    static constexpr bool PERM = true, AFTER_DRAIN = false, NEEDS_LDS = false;
    const float* xin; short* yq; const float* stats; const float* gam; const float* bet; float alpha; int norm;
    __device__ __forceinline__ void operator()(f32x4 (&acc)[2][2][4][2], const Unit& u, int wr, int wc, int fr, int fq) const {
        asm volatile("" ::: "memory");
        const int row0 = u.pm * BM + wr * 64 + fr, col0 = u.pn * BM + wc * 32 + 8 * fq;
        f32x4 gv[2][2], bv[2][2];
        if (norm) {
#pragma unroll
            for (int bj = 0; bj < 2; ++bj)
#pragma unroll
                for (int n = 0; n < 2; ++n) { gv[bj][n] = *(const f32x4*)(gam + col0 + bj * HALF + n * 4); bv[bj][n] = *(const f32x4*)(bet + col0 + bj * HALF + n * 4); }
        }
        if (norm) {
            u32x4 qa[4][2], qb[4][2]; float sca[4], sha[4], scb[4], shb[4];
#define ER_LOAD(q, s, t, ai, h) do { const int row_ = row0 + (ai) * HALF + (h) * 16; const size_t off_ = (size_t)row_ * 2048 + col0; const float mean_ = stats[2 * row_], rstd_ = stats[2 * row_ + 1]; s[h] = rstd_; t[h] = -mean_ * rstd_; \
                q[h][0] = *(const u32x4*)(yq + off_); q[h][1] = *(const u32x4*)(yq + off_ + HALF); } while (0)
#define ER_DO(q, s, t, ai, h) do { const size_t off_ = (size_t)(row0 + (ai) * HALF + (h) * 16) * 2048 + col0; \
                _Pragma("unroll") for (int bj = 0; bj < 2; ++bj) { u32x4 o; \
                    _Pragma("unroll") for (int n = 0; n < 2; ++n) { const unsigned w0 = q[h][bj][2 * n], w1 = q[h][bj][2 * n + 1]; \
                        f32x4 qq; qq[0] = h_lo(w0); qq[1] = h_hi(w0); qq[2] = h_lo(w1); qq[3] = h_hi(w1); \
                        const f32x4 x = (qq * s[h] + t[h]) * gv[bj][n] + bv[bj][n]; const f32x4 y = x * alpha + acc[ai][bj][h][n]; \
                        o[2 * n] = h2_pack(y[0], y[1]); o[2 * n + 1] = h2_pack(y[2], y[3]); } \
                    *(u32x4*)(yq + off_ + bj * HALF) = o; } } while (0)
            ER_LOAD(qa, sca, sha, 0, 0); ER_LOAD(qa, sca, sha, 0, 1); ER_LOAD(qa, sca, sha, 0, 2); ER_LOAD(qa, sca, sha, 0, 3);
            asm volatile("" ::: "memory");
            ER_DO(qa, sca, sha, 0, 0); ER_DO(qa, sca, sha, 0, 1);
            asm volatile("" ::: "memory");
            ER_LOAD(qb, scb, shb, 1, 0); ER_LOAD(qb, scb, shb, 1, 1);
            asm volatile("" ::: "memory");
            ER_DO(qa, sca, sha, 0, 2); ER_DO(qa, sca, sha, 0, 3);
            asm volatile("" ::: "memory");
            ER_LOAD(qb, scb, shb, 1, 2); ER_LOAD(qb, scb, shb, 1, 3);
            asm volatile("" ::: "memory");
            ER_DO(qb, scb, shb, 1, 0); ER_DO(qb, scb, shb, 1, 1); ER_DO(qb, scb, shb, 1, 2); ER_DO(qb, scb, shb, 1, 3);
            asm volatile("" ::: "memory");
#undef ER_LOAD
#undef ER_DO
        } else {
#pragma unroll
            for (int ai = 0; ai < 2; ++ai)
#pragma unroll
                for (int m = 0; m < 4; ++m) { const size_t off = (size_t)(row0 + ai * HALF + m * 16) * 2048 + col0;
                    f32x4 xv[2][2];
#pragma unroll
                    for (int bj = 0; bj < 2; ++bj)
#pragma unroll
                        for (int n = 0; n < 2; ++n) xv[bj][n] = *(const f32x4*)(xin + off + bj * HALF + n * 4);
#pragma unroll
                    for (int bj = 0; bj < 2; ++bj) { u32x4 o;
#pragma unroll
                        for (int n = 0; n < 2; ++n) { const f32x4 y = xv[bj][n] * alpha + acc[ai][bj][m][n]; o[2 * n] = h2_pack(y[0], y[1]); o[2 * n + 1] = h2_pack(y[2], y[3]); }
                        *(u32x4*)(yq + off + bj * HALF) = o; }
                    asm volatile("" ::: "memory"); }
        }
    }
};

template <int N> __device__ __forceinline__ float row_ror(float v) { return __builtin_bit_cast(float, __builtin_amdgcn_update_dpp(0, __builtin_bit_cast(int, v), 0x120 + N, 0xf, 0xf, false)); }
template <int CTRL> __device__ __forceinline__ float dpp0(float v) { return __builtin_bit_cast(float, __builtin_amdgcn_update_dpp(0, __builtin_bit_cast(int, v), CTRL, 0xf, 0xf, true)); }
struct EpiFfnUp {
    static constexpr bool PERM = true, AFTER_DRAIN = false, NEEDS_LDS = true;
    bf16_t* ACT; float* HALO; const float* cw; const float* cb;
    __device__ __forceinline__ void run(f32x4 (&acc)[2][2][4][2], const Unit& u, int wr, int wc, int fr, int fq, PG8_LAS unsigned char* xl) const {
        PG8_LAS float* X = (PG8_LAS float*)xl;
        const int lane = fq * 16 + fr, cc0 = 32 * wc + 8 * fq;
        f32x4 cwv[2][2][4];
#pragma unroll
        for (int n = 0; n < 2; ++n)
#pragma unroll
            for (int bj = 0; bj < 2; ++bj) { const int col = bj * 5504 + u.pn * 128 + cc0 + 4 * n;
                cwv[n][bj][0] = *(const f32x4*)(cw + col); cwv[n][bj][1] = *(const f32x4*)(cw + 11008 + col); cwv[n][bj][2] = *(const f32x4*)(cw + 22016 + col); cwv[n][bj][3] = *(const f32x4*)(cb + col); }
        __builtin_amdgcn_sched_barrier(0);
        if (fr >= 14) {
#pragma unroll
            for (int ai = 0; ai < 2; ++ai) { const int sg = 2 * ai + wr;
#pragma unroll
                for (int bj = 0; bj < 2; ++bj)
#pragma unroll
                    for (int n = 0; n < 2; ++n) *(PG8_LAS f32x4*)(X + ((sg * 2 + (fr - 14)) * 256 + bj * 128 + cc0 + 4 * n)) = acc[ai][bj][3][n]; }
            if (wr == 1) {
                float* hp = HALO + ((size_t)u.pm * 4 + 2 + (fr - 14)) * 11008 + u.pn * 256 + cc0;
#pragma unroll
                for (int bj = 0; bj < 2; ++bj)
#pragma unroll
                    for (int n = 0; n < 2; ++n) *(f32x4*)(hp + bj * 128 + 4 * n) = acc[1][bj][3][n];
            }
        }
        if (fr < 2 && wr == 0) {
            float* hp = HALO + ((size_t)u.pm * 4 + fr) * 11008 + u.pn * 256 + cc0;
#pragma unroll
            for (int bj = 0; bj < 2; ++bj)
#pragma unroll
                for (int n = 0; n < 2; ++n) *(f32x4*)(hp + bj * 128 + 4 * n) = acc[0][bj][0][n];
        }
        asm volatile("s_waitcnt lgkmcnt(0)" ::: "memory"); __builtin_amdgcn_s_barrier(); asm volatile("" ::: "memory");
        f32x4 Qv[2][2][2];
#pragma unroll
        for (int n = 0; n < 2; ++n)
#pragma unroll
            for (int bj = 0; bj < 2; ++bj)
#pragma unroll
                for (int ai = 0; ai < 2; ++ai) { const int sg = 2 * ai + wr; Qv[n][bj][ai] = (f32x4){0.f, 0.f, 0.f, 0.f};
                    if (sg > 0) Qv[n][bj][ai] = *(const PG8_LAS f32x4*)(X + (((sg - 1) * 2 + (fr & 1)) * 256 + bj * 128 + cc0 + 4 * n)); }
        __builtin_amdgcn_sched_barrier(0);
#pragma unroll
        for (int n = 0; n < 2; ++n) {
#pragma unroll
            for (int bj = 0; bj < 2; ++bj) {
                const f32x4 w0 = cwv[n][bj][0], w1 = cwv[n][bj][1], w2 = cwv[n][bj][2], bb = cwv[n][bj][3];
#pragma unroll
                for (int ai = 0; ai < 2; ++ai) { const int sg = 2 * ai + wr;
                    const f32x4 Q = Qv[n][bj][ai];
                    asm volatile("" : "+v"(acc[ai][bj][0][n]), "+v"(acc[ai][bj][1][n]), "+v"(acc[ai][bj][2][n]), "+v"(acc[ai][bj][3][n]));
#pragma unroll
                    for (int m = 3; m >= 0; --m) {
                        const f32x4 cur = acc[ai][bj][m][n], prv = m > 0 ? acc[ai][bj][m - 1][n] : Q;
                        f32x4 o = w2 * cur + bb;
                        float o0 = o[0], o1 = o[1], o2 = o[2], o3 = o[3];
                        asm volatile("s_nop 1\n\t"
                            "v_fmac_f32_dpp %0, %4, %12 row_shr:1 row_mask:0xf bank_mask:0xf\n\tv_fmac_f32_dpp %1, %5, %13 row_shr:1 row_mask:0xf bank_mask:0xf\n\t"
                            "v_fmac_f32_dpp %2, %6, %14 row_shr:1 row_mask:0xf bank_mask:0xf\n\tv_fmac_f32_dpp %3, %7, %15 row_shr:1 row_mask:0xf bank_mask:0xf\n\t"
                            "v_fmac_f32_dpp %0, %8, %12 row_shl:15 row_mask:0xf bank_mask:0xf\n\tv_fmac_f32_dpp %1, %9, %13 row_shl:15 row_mask:0xf bank_mask:0xf\n\t"
                            "v_fmac_f32_dpp %2, %10, %14 row_shl:15 row_mask:0xf bank_mask:0xf\n\tv_fmac_f32_dpp %3, %11, %15 row_shl:15 row_mask:0xf bank_mask:0xf\n\t"
                            "v_fmac_f32_dpp %0, %4, %16 row_shr:2 row_mask:0xf bank_mask:0xf\n\tv_fmac_f32_dpp %1, %5, %17 row_shr:2 row_mask:0xf bank_mask:0xf\n\t"
                            "v_fmac_f32_dpp %2, %6, %18 row_shr:2 row_mask:0xf bank_mask:0xf\n\tv_fmac_f32_dpp %3, %7, %19 row_shr:2 row_mask:0xf bank_mask:0xf\n\t"
                            "v_fmac_f32_dpp %0, %8, %16 row_shl:14 row_mask:0xf bank_mask:0xf\n\tv_fmac_f32_dpp %1, %9, %17 row_shl:14 row_mask:0xf bank_mask:0xf\n\t"
                            "v_fmac_f32_dpp %2, %10, %18 row_shl:14 row_mask:0xf bank_mask:0xf\n\tv_fmac_f32_dpp %3, %11, %19 row_shl:14 row_mask:0xf bank_mask:0xf"
                            : "+v"(o0), "+v"(o1), "+v"(o2), "+v"(o3)
                            : "v"(cur[0]), "v"(cur[1]), "v"(cur[2]), "v"(cur[3]), "v"(prv[0]), "v"(prv[1]), "v"(prv[2]), "v"(prv[3]),
                              "v"(w1[0]), "v"(w1[1]), "v"(w1[2]), "v"(w1[3]), "v"(w0[0]), "v"(w0[1]), "v"(w0[2]), "v"(w0[3]));
                        o[0] = o0; o[1] = o1; o[2] = o2; o[3] = o3;
                        acc[ai][bj][m][n] = o;
                    }
                    asm volatile("" : "+v"(acc[ai][bj][0][n]), "+v"(acc[ai][bj][1][n]), "+v"(acc[ai][bj][2][n]), "+v"(acc[ai][bj][3][n]));
                    __builtin_amdgcn_sched_barrier(0);
                }
            }
        }
        const int row0 = u.pm * BM + wr * 64 + fr;
#pragma unroll
        for (int ai = 0; ai < 2; ++ai)
#pragma unroll
            for (int m = 0; m < 4; ++m) {
                f32x4 a[2];
#pragma unroll
                for (int n = 0; n < 2; ++n) { const f32x4 g = acc[ai][0][m][n], up = acc[ai][1][m][n]; const f32x4 t = g * -1.4426950408889634f; f32x4 e;
#pragma unroll
                    for (int i = 0; i < 4; ++i) e[i] = __builtin_amdgcn_exp2f(t[i]);
                    const f32x4 d = e + 1.f; f32x4 r;
#pragma unroll
                    for (int i = 0; i < 4; ++i) r[i] = __builtin_amdgcn_rcpf(d[i]);
                    a[n] = (g * up) * r; }
                u32x4 w; w.x = cvt_pk_bf16(a[0][0], a[0][1]); w.y = cvt_pk_bf16(a[0][2], a[0][3]); w.z = cvt_pk_bf16(a[1][0], a[1][1]); w.w = cvt_pk_bf16(a[1][2], a[1][3]);
                if (!(ai == 0 && m == 0 && wr == 0 && fr < 2)) __builtin_nontemporal_store(w, (u32x4*)(ACT + (size_t)(row0 + ai * HALF + m * 16) * 5504 + u.pn * 128 + cc0));
            }
    }
};

template <class Epi, class Sched, bool ALIGN_EPI = false, bool SP2 = false>
__device__ __forceinline__ void gemm_phase(PG8_LAS unsigned char* lds, const Gemm g, const Sched& S, const Epi& E, int wv) {
    const int tid = fresh_tid(wv), wid = __builtin_amdgcn_readfirstlane(tid >> 6), lane = tid & 63, wr = wid >> 2, wc = wid & 3, fr = lane & 15, fq = lane >> 4;
    const int K = g.K, nt = K / BK;
    unsigned voffA[2], voffB[2];
#pragma unroll
    for (int i = 0; i < 2; ++i) { int R, C; stage_rc(tid * 16 + i * 8192, R, C); const int Rb = Epi::PERM ? ((R & ~31) + perm32(R & 31)) : R;
        voffA[i] = (unsigned)(R * g.lda + C) * 2u; voffB[i] = (unsigned)(Rb * g.ldb + C) * 2u; }
    const size_t kstep = (size_t)(BK * 2);
    const size_t hstepA = (size_t)HALF * g.lda * 2, hstepB = (size_t)HALF * g.ldb * 2;
    const size_t tstepA = 2 * hstepA, tstepB = 2 * hstepB;
    const unsigned ldsw = (unsigned)wid * 1024u;
    const int aoff = lds_byte(wr * 64 + fr, fq * 8), boff = lds_byte(wc * 32 + fr, fq * 8);
#define PG8_SA(b, h) (((b) * 2 + (h)) * HTB)
#define PG8_SB(b, h) ((4 + (b) * 2 + (h)) * HTB)
#define PG8_STAGE(bufoff, gbase, voff) do { _Pragma("unroll") for (int _i = 0; _i < 2; ++_i) \
        __builtin_amdgcn_global_load_lds((const unsigned*)((const char*)(gbase) + (voff)[_i]), (PG8_LAS unsigned*)(lds + (bufoff) + ldsw + _i * 8192), 16, 0, 0); } while (0)
#define PG8_LDA(dst, b, h) do { _Pragma("unroll") for (int m = 0; m < 4; ++m) _Pragma("unroll") for (int k = 0; k < 2; ++k) dst[m][k] = *(const PG8_LAS bf16x8*)(lds + PG8_SA(b, h) + aoff + m * 2048 + k * 1024); } while (0)
#define PG8_LDB(dst, b, h) do { _Pragma("unroll") for (int n = 0; n < 2; ++n) _Pragma("unroll") for (int k = 0; k < 2; ++k) dst[n][k] = *(const PG8_LAS bf16x8*)(lds + PG8_SB(b, h) + boff + n * 2048 + k * 1024); } while (0)
#define PG8_MMA(ai, bj, At, Bt) do { __builtin_amdgcn_s_setprio(1); _Pragma("unroll") for (int m = 0; m < 4; ++m) _Pragma("unroll") for (int n = 0; n < 2; ++n) _Pragma("unroll") for (int k = 0; k < 2; ++k) \
        acc[ai][bj][m][n] = __builtin_amdgcn_mfma_f32_16x16x32_bf16(Bt[n][k], At[m][k], acc[ai][bj][m][n], 0, 0, 0); __builtin_amdgcn_s_setprio(0); } while (0)
#define PG8_WAIT_V(n) asm volatile("s_waitcnt vmcnt(" #n ")" ::: "memory")
#define PG8_WAIT_L(n) asm volatile("s_waitcnt lgkmcnt(" #n ")" ::: "memory")
#define PG8_BAR __builtin_amdgcn_s_barrier()
#define PG8_SCHED __builtin_amdgcn_sched_barrier(0)
    Unit cur, nxt; int ui = 0;
    if (!S.next(0, cur)) return;
    f32x4 acc[2][2][4][2];
#pragma unroll
    for (int a = 0; a < 2; ++a)
#pragma unroll
        for (int b = 0; b < 2; ++b)
#pragma unroll
            for (int m = 0; m < 4; ++m)
#pragma unroll
                for (int n = 0; n < 2; ++n) acc[a][b][m][n] = (f32x4){0.f, 0.f, 0.f, 0.f};
    bf16x8 At[4][2], B0[2][2], B1[2][2];
    const char* cA = (const char*)g.A + (size_t)cur.pm * tstepA; const char* cB = (const char*)g.Bt + (size_t)cur.pn * tstepB;
    S.a_ready(cur);
    if constexpr (SP2) {
        PG8_STAGE(PG8_SB(0, 0), cB, voffB); PG8_STAGE(PG8_SB(0, 1), cB + hstepB, voffB); PG8_STAGE(PG8_SA(0, 0), cA, voffA); PG8_STAGE(PG8_SA(0, 1), cA + hstepA, voffA);
        if (wr == 1) PG8_BAR;
        PG8_WAIT_V(2); PG8_BAR;
        PG8_STAGE(PG8_SB(1, 0), cB + kstep, voffB); PG8_STAGE(PG8_SA(1, 0), cA + kstep, voffA); PG8_STAGE(PG8_SB(1, 1), cB + hstepB + kstep, voffB);
        PG8_WAIT_V(6); PG8_BAR;
    } else {
        PG8_STAGE(PG8_SB(0, 0), cB, voffB); PG8_STAGE(PG8_SA(0, 0), cA, voffA); PG8_STAGE(PG8_SB(0, 1), cB + hstepB, voffB); PG8_STAGE(PG8_SA(0, 1), cA + hstepA, voffA);
        if (wr == 1) PG8_BAR;
        PG8_WAIT_V(4); PG8_BAR;
        PG8_STAGE(PG8_SB(1, 0), cB + kstep, voffB); PG8_STAGE(PG8_SA(1, 0), cA + kstep, voffA); PG8_STAGE(PG8_SB(1, 1), cB + hstepB + kstep, voffB);
        PG8_WAIT_V(6); PG8_BAR;
    }
    for (;;) {
        const bool has_next = S.next(ui + 1, nxt);
        const char* nA = has_next ? (const char*)g.A + (size_t)nxt.pm * tstepA : cA; const char* nB = has_next ? (const char*)g.Bt + (size_t)nxt.pn * tstepB : cB;
        for (int t = 0; t < nt; t += 2) {
            const bool last = (t == nt - 2);
            const char* a1 = cA + (size_t)(t + 1) * kstep;
            const char* a2 = last ? nA : cA + (size_t)(t + 2) * kstep; const char* b2 = last ? nB : cB + (size_t)(t + 2) * kstep;
            const char* a3 = a2 + kstep; const char* b3 = b2 + kstep;
            asm volatile("" : "+s"(a3), "+s"(b3));
            if (last && has_next) S.a_ready(nxt);
            asm volatile("" : "+v"(voffA[0]), "+v"(voffA[1]), "+v"(voffB[0]), "+v"(voffB[1]));
            if constexpr (SP2) {
            PG8_LDB(B0, 0, 0); PG8_LDB(B1, 0, 1); PG8_SCHED; PG8_LDA(At, 0, 0); PG8_STAGE(PG8_SA(1, 1), a1 + hstepA, voffA);
            PG8_WAIT_V(8); PG8_WAIT_L(0); PG8_BAR; PG8_MMA(0, 0, At, B0); PG8_MMA(0, 1, At, B1); PG8_BAR; PG8_SCHED;
            PG8_LDA(At, 0, 1); PG8_STAGE(PG8_SB(0, 0), b2, voffB); PG8_STAGE(PG8_SB(0, 1), b2 + hstepB, voffB); PG8_STAGE(PG8_SA(0, 0), a2, voffA);
            PG8_WAIT_V(8); PG8_WAIT_L(0); PG8_BAR; PG8_MMA(1, 0, At, B0); PG8_MMA(1, 1, At, B1); PG8_BAR; PG8_SCHED;
            PG8_LDB(B0, 1, 0); PG8_LDB(B1, 1, 1); PG8_SCHED; PG8_LDA(At, 1, 0); PG8_STAGE(PG8_SA(0, 1), a2 + hstepA, voffA);
            PG8_WAIT_V(8); PG8_WAIT_L(0); PG8_BAR; PG8_MMA(0, 0, At, B0); PG8_MMA(0, 1, At, B1); PG8_BAR; PG8_SCHED;
            PG8_LDA(At, 1, 1); PG8_STAGE(PG8_SB(1, 0), b3, voffB); PG8_STAGE(PG8_SB(1, 1), b3 + hstepB, voffB); PG8_STAGE(PG8_SA(1, 0), a3, voffA);
            PG8_WAIT_V(8); PG8_WAIT_L(0); PG8_BAR; PG8_MMA(1, 0, At, B0); PG8_MMA(1, 1, At, B1); PG8_BAR; PG8_SCHED;
            } else {
            PG8_LDB(B0, 0, 0); PG8_SCHED; PG8_LDA(At, 0, 0); PG8_STAGE(PG8_SA(1, 1), a1 + hstepA, voffA);
            PG8_WAIT_L(8); PG8_BAR; PG8_WAIT_L(0); PG8_MMA(0, 0, At, B0); PG8_BAR; PG8_SCHED;
            PG8_LDB(B1, 0, 1); PG8_STAGE(PG8_SB(0, 0), b2, voffB);
            PG8_BAR; PG8_WAIT_L(0); PG8_MMA(0, 1, At, B1); PG8_BAR;
            PG8_LDA(At, 0, 1); PG8_STAGE(PG8_SA(0, 0), a2, voffA);
            PG8_BAR; PG8_WAIT_L(0); PG8_MMA(1, 0, At, B0); PG8_BAR; PG8_SCHED;
            PG8_STAGE(PG8_SB(0, 1), b2 + hstepB, voffB);
            PG8_WAIT_V(6); PG8_BAR; PG8_MMA(1, 1, At, B1); PG8_BAR;
            PG8_LDB(B0, 1, 0); PG8_SCHED; PG8_LDA(At, 1, 0); PG8_STAGE(PG8_SA(0, 1), a2 + hstepA, voffA);
            PG8_WAIT_L(8); PG8_BAR; PG8_WAIT_L(0); PG8_MMA(0, 0, At, B0); PG8_BAR; PG8_SCHED;
            PG8_LDB(B1, 1, 1); PG8_STAGE(PG8_SB(1, 0), b3, voffB);
            PG8_BAR; PG8_WAIT_L(0); PG8_MMA(0, 1, At, B1); PG8_BAR;
            PG8_LDA(At, 1, 1); PG8_STAGE(PG8_SA(1, 0), a3, voffA);
            PG8_BAR; PG8_WAIT_L(0); PG8_MMA(1, 0, At, B0); PG8_BAR; PG8_SCHED;
            PG8_STAGE(PG8_SB(1, 1), b3 + hstepB, voffB);
            PG8_WAIT_V(6); PG8_BAR; PG8_MMA(1, 1, At, B1); PG8_BAR;
            }
        }
        if constexpr (ALIGN_EPI) { if (wr == 0) PG8_BAR; }
        { const int le_ = fresh_tid(wv) & 63, fre_ = le_ & 15, fqe_ = le_ >> 4;
          if constexpr (Epi::NEEDS_LDS) { static_assert(ALIGN_EPI, "an epilogue with a workgroup barrier needs both halves in it together"); E.run(acc, cur, wr, wc, fre_, fqe_, lds + STAGE_BYTES); S.done(cur); }
          else { E(acc, cur, wr, wc, fre_, fqe_); S.done(cur); } }
        if (!has_next) break;
#pragma unroll
        for (int a = 0; a < 2; ++a)
#pragma unroll
            for (int b = 0; b < 2; ++b)
#pragma unroll
                for (int m = 0; m < 4; ++m)
#pragma unroll
                    for (int n = 0; n < 2; ++n) acc[a][b][m][n] = (f32x4){0.f, 0.f, 0.f, 0.f};
        cur = nxt; cA = nA; cB = nB; ++ui;
        if constexpr (ALIGN_EPI) { if (wr == 1) PG8_BAR; }
    }
    PG8_WAIT_V(0);
    if constexpr (!ALIGN_EPI) { if (wr == 0) PG8_BAR; }
    PG8_BAR;
#undef PG8_SA
#undef PG8_SB
#undef PG8_STAGE
#undef PG8_LDA
#undef PG8_LDB
#undef PG8_MMA
#undef PG8_WAIT_V
#undef PG8_WAIT_L
#undef PG8_BAR
#undef PG8_SCHED
}
}

#define LAS __attribute__((address_space(3)))
typedef unsigned short bf16;
typedef float f32x4 __attribute__((ext_vector_type(4)));
typedef unsigned u32x4 __attribute__((ext_vector_type(4)));
typedef unsigned u32x2 __attribute__((ext_vector_type(2)));

constexpr int DM = 2048, BATCH = 16, SEQ = 2048, MTOK = BATCH * SEQ, DEPTH = 4;
constexpr int GLA_H = 4, GLA_DK = 1024, GLA_DV = 2048, GLA_HK = 256, GLA_HV = 512, GLA_RANK = 16, GLA_IN = 6160, GLA_NPAD = 6400;
constexpr int DIL_HEADS = 8, DIL_HD = 128, DIL_WIDTH = 1024, DIL_IN = 9216;
constexpr int DFF = 5504, NUP = 2 * DFF;
constexpr float ALPHA = 1.6817928305074292f;
constexpr float LN_EPS = 1e-5f, RMS_EPS = 1e-6f;
constexpr float LOG2E = 1.4426950408889634f;

constexpr size_t MiB = 1u << 20;
constexpr size_t WS_CTL = 0;
constexpr size_t WS_WGI = 2 * MiB;
constexpr size_t WS_WGO = WS_WGI + 50 * MiB;
constexpr size_t WS_WDI = WS_WGO + 16 * MiB;
constexpr size_t WS_WDO = WS_WDI + 72 * MiB;
constexpr size_t WS_WUP = WS_WDO + 8 * MiB;
constexpr size_t WS_WDN = WS_WUP + 172 * MiB;
constexpr size_t WS_YQ  = WS_WDN + 86 * MiB;
constexpr size_t WS_HALO = WS_YQ + 128 * MiB;
constexpr size_t WS_STATS = WS_HALO + 22544384;
constexpr size_t WS_REG = WS_HALO + 22 * MiB;
static_assert(WS_STATS + (size_t)MTOK * 8 <= WS_REG, "stats fit behind the halo rows");
constexpr size_t WS_QK = WS_REG, WS_V = WS_QK + 128 * MiB, WS_R = WS_V + 128 * MiB, WS_GLOW = WS_R + 128 * MiB, WS_IMG = WS_GLOW + 2 * MiB, WS_VT = WS_IMG + 146 * MiB, WS_O = WS_QK;
constexpr size_t WS_PROJ = WS_REG, WS_OG = WS_PROJ + 576 * MiB, WS_LSE = WS_OG + 192 * MiB;
constexpr size_t WS_ACT = WS_REG;
constexpr size_t WS_END = WS_REG + 771 * MiB;

__device__ __forceinline__ unsigned f2bf(float f) { unsigned u = __builtin_bit_cast(unsigned, f); return (u + 0x7fffu + ((u >> 16) & 1u)) >> 16; }
__device__ __forceinline__ unsigned pk2(float lo, float hi) { return f2bf(lo) | (f2bf(hi) << 16); }
__device__ __forceinline__ float bf2f(unsigned short b) { return __builtin_bit_cast(float, (unsigned)b << 16); }
__device__ __forceinline__ float bflo(unsigned w) { return __builtin_bit_cast(float, w << 16); }
__device__ __forceinline__ float bfhi(unsigned w) { return __builtin_bit_cast(float, w & 0xffff0000u); }
__device__ __forceinline__ float wave_sum(float v) {
#define WS_DPP_ADD(ctrl, rmask) v += __builtin_bit_cast(float, __builtin_amdgcn_update_dpp(0, __builtin_bit_cast(int, v), ctrl, rmask, 0xf, true))
    WS_DPP_ADD(0x111, 0xf); WS_DPP_ADD(0x112, 0xf); WS_DPP_ADD(0x114, 0xf); WS_DPP_ADD(0x118, 0xf); WS_DPP_ADD(0x142, 0xa); WS_DPP_ADD(0x143, 0xc);
#undef WS_DPP_ADD
    return __builtin_bit_cast(float, __builtin_amdgcn_readlane(__builtin_bit_cast(int, v), 63));
}

struct Params {
    const float* x; const float* gla_w_in; const float* gla_wgu; const float* gla_gbias; const float* gla_norm_g; const float* gla_w_out;
    const float* dil_w_in; const float* dil_w_out; const float* ffn_w_up; const float* conv_w; const float* conv_b; const float* ffn_w_down;
    const float* ln_g; const float* ln_b; float* out; unsigned char* ws;
};

__device__ __forceinline__ void transpose_item(const float* W, int K, int N, bf16* WT, int dest_row0, LAS float* scr, int k0, int n0, int lane) {
#pragma unroll 8
    for (int i = 0; i < 32; ++i) { const int kk = 2 * i + (lane >> 5); scr[kk * 33 + (lane & 31)] = W[(size_t)(k0 + kk) * N + n0 + (lane & 31)]; }
    asm volatile("s_waitcnt lgkmcnt(0)" ::: "memory");
    const int c = lane & 7;
#pragma unroll
    for (int j = 0; j < 4; ++j) { const int n = (lane >> 3) + 8 * j; const LAS float* s = scr + (8 * c) * 33 + n;
        u32x4 o; o.x = pk2(s[0 * 33], s[1 * 33]); o.y = pk2(s[2 * 33], s[3 * 33]); o.z = pk2(s[4 * 33], s[5 * 33]); o.w = pk2(s[6 * 33], s[7 * 33]);
        *(u32x4*)(WT + (size_t)(dest_row0 + n) * K + k0 + 8 * c) = o; }
    asm volatile("s_waitcnt lgkmcnt(0)" ::: "memory");
}
template <int MAP> __device__ __forceinline__ void transpose_matrix(const float* W, int K, int N, int ncols, bf16* WT, LAS float* scr, int gw, int ngw, int lane) {
    const int nnb = ncols / 32, items = (K / 64) * nnb;
    for (int it = gw; it < items; it += ngw) {
        const int kb = it / nnb, nb = it % nnb, n0 = nb * 32;
        int dr = n0;
        if (MAP == 1) { dr = n0 < DFF ? 256 * (n0 / 128) + (n0 % 128) : 256 * ((n0 - DFF) / 128) + 128 + ((n0 - DFF) % 128); }
        transpose_item(W, K, N, WT, dr, scr, kb * 64, n0, lane);
    }
}
__device__ __forceinline__ void prologue(const Params& P, LAS unsigned char* lds, int bx, int G, int wv) {
    const int tid = fresh_tid(wv), lane = tid & 63, wave = tid >> 6;
    LAS float* scr = (LAS float*)(lds + wave * 8448);
    const int gw = bx * 8 + wave, ngw = G * 8;
    unsigned char* ws = P.ws;
    for (int j = 0; j < 2; ++j) {
        transpose_matrix<0>(P.gla_w_in + (size_t)j * DM * GLA_IN, DM, GLA_IN, 6144, (bf16*)(ws + WS_WGI) + (size_t)j * GLA_NPAD * DM, scr, gw, ngw, lane);
        transpose_matrix<0>(P.gla_w_out + (size_t)j * GLA_DV * DM, GLA_DV, DM, DM, (bf16*)(ws + WS_WGO) + (size_t)j * DM * GLA_DV, scr, gw, ngw, lane);
        transpose_matrix<0>(P.dil_w_in + (size_t)j * DM * DIL_IN, DM, DIL_IN, DIL_IN, (bf16*)(ws + WS_WDI) + (size_t)j * DIL_IN * DM, scr, gw, ngw, lane);
        transpose_matrix<0>(P.dil_w_out + (size_t)j * DIL_WIDTH * DM, DIL_WIDTH, DM, DM, (bf16*)(ws + WS_WDO) + (size_t)j * DM * DIL_WIDTH, scr, gw, ngw, lane);
    }
    for (int i = 0; i < 4; ++i) {
        transpose_matrix<1>(P.ffn_w_up + (size_t)i * DM * NUP, DM, NUP, NUP, (bf16*)(ws + WS_WUP) + (size_t)i * NUP * DM, scr, gw, ngw, lane);
        transpose_matrix<0>(P.ffn_w_down + (size_t)i * DFF * DM, DFF, DM, DM, (bf16*)(ws + WS_WDN) + (size_t)i * DM * DFF, scr, gw, ngw, lane);
    }
    const size_t gt = (size_t)bx * 512 + tid, ngt = (size_t)G * 512;
    for (size_t idx = gt; idx < (size_t)2 * 256 * DM; idx += ngt) {
        const int j = (int)(idx / (256 * DM)), r = (int)((idx / DM) % 256), k = (int)(idx % DM);
        const float v = r < 16 ? P.gla_w_in[(size_t)j * DM * GLA_IN + (size_t)k * GLA_IN + 6144 + r] : 0.f;
        ((bf16*)(ws + WS_WGI))[(size_t)j * GLA_NPAD * DM + (size_t)(6144 + r) * DM + k] = (bf16)f2bf(v);
    }
    for (size_t idx = gt; idx < (size_t)MTOK * DM / 4; idx += ngt) {
        const f32x4 v = ((const f32x4*)P.x)[idx];
        u32x2 o; o.x = pk2(v[0], v[1]); o.y = pk2(v[2], v[3]);
        ((u32x2*)P.out)[idx] = o;
    }
}

template <bool FINAL>
__device__ __forceinline__ void ln_rows(const short* yq, float* xo, bf16* xb, float* stats, const float* g, const float* b, int gw, int ngw, int lane) {
    f32x4 gv[8], bv[8];
#pragma unroll
    for (int j = 0; j < 4; ++j) { gv[2 * j] = *(const f32x4*)(g + 512 * j + 8 * lane); gv[2 * j + 1] = *(const f32x4*)(g + 512 * j + 8 * lane + 4);
        bv[2 * j] = *(const f32x4*)(b + 512 * j + 8 * lane); bv[2 * j + 1] = *(const f32x4*)(b + 512 * j + 8 * lane + 4); }
#pragma clang loop unroll(disable)
    for (int row = gw; row < MTOK; row += ngw) {
        u32x4 qv[4];
#pragma unroll
        for (int j = 0; j < 4; ++j) qv[j] = *((const u32x4*)(yq + (size_t)row * DM + 512 * j) + lane);
        f32x4 v[8]; float s = 0.f;
#pragma unroll
        for (int j = 0; j < 4; ++j)
#pragma unroll
            for (int i = 0; i < 4; ++i) { const unsigned w = qv[j][i]; const float lo = h_lo(w), hi = h_hi(w);
                v[2 * j + (i >> 1)][2 * (i & 1)] = lo; v[2 * j + (i >> 1)][2 * (i & 1) + 1] = hi; s += lo + hi; }
        const float mean = wave_sum(s) * (1.f / DM); float s2 = 0.f;
#pragma unroll
        for (int j = 0; j < 8; ++j) { v[j] = v[j] - mean; s2 += (v[j][0] * v[j][0] + v[j][1] * v[j][1]) + (v[j][2] * v[j][2] + v[j][3] * v[j][3]); }
        const float rstd = 1.f / sqrtf(wave_sum(s2) * (1.f / DM) + LN_EPS);
        if (FINAL) {
#pragma unroll
            for (int j = 0; j < 4; ++j) { float* xr = xo + (size_t)row * DM + 512 * j + 8 * lane;
                *(f32x4*)xr = v[2 * j] * rstd * gv[2 * j] + bv[2 * j]; *(f32x4*)(xr + 4) = v[2 * j + 1] * rstd * gv[2 * j + 1] + bv[2 * j + 1]; }
        } else {
            if (lane == 0) { stats[2 * row] = mean; stats[2 * row + 1] = rstd; }
#pragma unroll
            for (int j = 0; j < 4; ++j) { const f32x4 o0 = v[2 * j] * rstd * gv[2 * j] + bv[2 * j], o1 = v[2 * j + 1] * rstd * gv[2 * j + 1] + bv[2 * j + 1];
                u32x4 w; w.x = pk2(o0[0], o0[1]); w.y = pk2(o0[2], o0[3]); w.z = pk2(o1[0], o1[1]); w.w = pk2(o1[2], o1[3]);
                *((u32x4*)(xb + (size_t)row * DM + 512 * j) + lane) = w; } }
    }
}
__device__ __forceinline__ void gatenorm_rows(const bf16* o, bf16* oo, const bf16* r, const float* ng, int gw, int ngw, int lane) {
    const f32x4 g0 = ((const f32x4*)ng)[2 * lane], g1 = ((const f32x4*)ng)[2 * lane + 1];
#pragma clang loop unroll(disable)
    for (int row = gw; row < MTOK; row += ngw) {
        u32x4 ov[4], rv[4];
#pragma unroll
        for (int k = 0; k < 4; ++k) { ov[k] = *((const u32x4*)(o + (size_t)row * DM + 512 * k) + lane); rv[k] = *((const u32x4*)(r + (size_t)row * DM + 512 * k) + lane); }
#pragma unroll
        for (int k = 0; k < 4; ++k) {
            float of[8], rf[8];
#pragma unroll
            for (int i = 0; i < 4; ++i) { of[2 * i] = bflo(ov[k][i]); of[2 * i + 1] = bfhi(ov[k][i]); rf[2 * i] = bflo(rv[k][i]); rf[2 * i + 1] = bfhi(rv[k][i]); }
            float ss = 0.f;
#pragma unroll
            for (int i = 0; i < 8; ++i) ss += of[i] * of[i];
            const float rstd = 1.f / sqrtf(wave_sum(ss) * (1.f / 512.f) + RMS_EPS);
            float res[8];
#pragma unroll
            for (int i = 0; i < 8; ++i) { const float gg = i < 4 ? g0[i] : g1[i - 4]; const float sl = rf[i] / (1.f + __expf(-rf[i])); res[i] = of[i] * rstd * gg * sl; }
            u32x4 w; w.x = pk2(res[0], res[1]); w.y = pk2(res[2], res[3]); w.z = pk2(res[4], res[5]); w.w = pk2(res[6], res[7]);
            *((u32x4*)(oo + (size_t)row * DM + 512 * k) + lane) = w;
        }
    }
}
__device__ __forceinline__ void combine_rows(const bf16* og, bf16* oo, const float* lse, int gw, int ngw, int lane) {
#pragma clang loop unroll(disable)
    for (int row = gw; row < MTOK; row += ngw) {
        u32x4 a[2], b[2], c[2]; float l0[2], l1[2], l2[2];
#pragma unroll
        for (int k = 0; k < 2; ++k) { const int h = 4 * k + (lane >> 4);
            l0[k] = lse[(size_t)row * 8 + h]; l1[k] = lse[(size_t)MTOK * 8 + (size_t)row * 8 + h]; l2[k] = lse[(size_t)2 * MTOK * 8 + (size_t)row * 8 + h];
            a[k] = *((const u32x4*)(og + (size_t)row * DIL_WIDTH + 512 * k) + lane);
            b[k] = *((const u32x4*)(og + (size_t)MTOK * DIL_WIDTH + (size_t)row * DIL_WIDTH + 512 * k) + lane);
            c[k] = *((const u32x4*)(og + (size_t)2 * MTOK * DIL_WIDTH + (size_t)row * DIL_WIDTH + 512 * k) + lane); }
#pragma unroll
        for (int k = 0; k < 2; ++k) {
            const float mx = fmaxf(l0[k], fmaxf(l1[k], l2[k]));
            float w0 = exp2f(l0[k] - mx), w1 = exp2f(l1[k] - mx), w2 = exp2f(l2[k] - mx); const float inv = 1.f / (w0 + w1 + w2); w0 *= inv; w1 *= inv; w2 *= inv;
            u32x4 w;
#pragma unroll
            for (int i = 0; i < 4; ++i) w[i] = pk2(w0 * bflo(a[k][i]) + w1 * bflo(b[k][i]) + w2 * bflo(c[k][i]), w0 * bfhi(a[k][i]) + w1 * bfhi(b[k][i]) + w2 * bfhi(c[k][i]));
            *((u32x4*)(oo + (size_t)row * DIL_WIDTH + 512 * k) + lane) = w;
        }
    }
}
namespace gla {
typedef short bf16x8 __attribute__((ext_vector_type(8)));
typedef float f32x2 __attribute__((ext_vector_type(2)));
typedef __bf16 bf16x2_t __attribute__((ext_vector_type(2)));
constexpr int BLOB = 74752, OFF_QI = 0, OFF_KT = 32768, OFF_AI = 65536, OFF_DEC = 73728;
__device__ __forceinline__ int swz(int ob) { return ob ^ (((ob >> 9) & 1) << 5); }
__device__ __forceinline__ int img_off(int r, int c, int CT) { return ((r >> 4) * CT + (c >> 5)) * 1024 + swz((r & 15) * 64 + (c & 31) * 2); }
__device__ __forceinline__ unsigned cvtpk(float lo, float hi) { f32x2 v = {lo, hi}; bf16x2_t b = __builtin_convertvector(v, bf16x2_t); return __builtin_bit_cast(unsigned, b); }
__device__ __forceinline__ float logsig(float z) { return fminf(z, 0.f) - 0.6931471805599453f * __builtin_amdgcn_logf(1.f + __builtin_amdgcn_exp2f(-1.4426950408889634f * fabsf(z))); }

__device__ __forceinline__ void prep(LAS unsigned char* lds, const bf16* QK, const bf16* V, const float* GLOW, const float* wgu, const float* gbias, unsigned char* IMG, bf16* VT, int wg, int nwg, int wv) {
    const int tid = fresh_tid(wv), lane = tid & 63, wid = __builtin_amdgcn_readfirstlane(tid >> 6);
    LAS unsigned char* QI = lds; LAS unsigned char* KI = lds + 32768; LAS unsigned char* KT = lds + 65536; LAS unsigned char* AI = lds + 98304;
    LAS float* WG = (LAS float*)(lds + 106496) + wid * 544;
    int hs = -1;
    for (int bi = wg; bi < BATCH * 32 * GLA_H; bi += nwg) {
        const int h = bi & 3, c = (bi >> 2) & 31, b = bi >> 7; const size_t T0 = (size_t)b * SEQ + 64 * c;
        unsigned char* blob = IMG + (size_t)bi * BLOB;
        const int P0 = 32 * wid;
        const size_t row = T0 + lane;
        f32x4 gl[4]; u32x4 qv4[4], kv4[4];
        { const bf16* qrow_ = QK + row * 2048 + 256 * h + P0;
#pragma unroll
          for (int i = 0; i < 4; ++i) gl[i] = *(const f32x4*)(GLOW + row * 16 + 4 * i);
#pragma unroll
          for (int i = 0; i < 4; ++i) { qv4[i] = *(const u32x4*)(qrow_ + 8 * i); kv4[i] = *(const u32x4*)(qrow_ + 1024 + 8 * i); } }
        if (h != hs) { hs = h; const int r = lane >> 2, p8 = 8 * (lane & 3); const float* src_ = wgu + (size_t)r * GLA_DK + 256 * h + P0 + p8;
          const f32x4 a0 = *(const f32x4*)src_, a1 = *(const f32x4*)(src_ + 4);
#pragma unroll
          for (int i = 0; i < 4; ++i) { WG[(p8 + i) * 16 + r] = a0[i]; WG[(p8 + 4 + i) * 16 + r] = a1[i]; }
          if (lane < 32) WG[512 + lane] = gbias[256 * h + P0 + lane]; }
        asm volatile("s_waitcnt lgkmcnt(0)" ::: "memory");
        float bb[32];
        { f32x4 Wa[4], Wb[4]; float Ba, Bb;
#define PREP_LW(W, B, p_) do { _Pragma("unroll") for (int j_ = 0; j_ < 4; ++j_) W[j_] = *(LAS f32x4*)(WG + (p_) * 16 + 4 * j_); B = WG[512 + (p_)]; __builtin_amdgcn_sched_barrier(0); } while (0)
#define PREP_MW(W, B, p_) do { f32x2 za_ = {B, 0.f}, zb_ = {0.f, 0.f}; _Pragma("unroll") for (int i_ = 0; i_ < 4; ++i_) { const f32x4 w_ = W[i_]; za_ = (f32x2){gl[i_][0], gl[i_][1]} * (f32x2){w_[0], w_[1]} + za_; zb_ = (f32x2){gl[i_][2], gl[i_][3]} * (f32x2){w_[2], w_[3]} + zb_; } za_ = za_ + zb_; bb[p_] = za_[0] + za_[1]; __builtin_amdgcn_sched_barrier(0); } while (0)
          PREP_LW(Wa, Ba, 0);
#pragma unroll
          for (int p2 = 0; p2 < 32; p2 += 2) { PREP_LW(Wb, Bb, p2 + 1); PREP_MW(Wa, Ba, p2); if (p2 + 2 < 32) PREP_LW(Wa, Ba, p2 + 2); PREP_MW(Wb, Bb, p2 + 1); }
#undef PREP_LW
#undef PREP_MW
        }
#pragma unroll
        for (int p = 0; p < 32; ++p) {
            const float z = bb[p];
            float v = logsig(z) * 0.0625f;
#define GLA_DPP_ADD(ctrl, rmask) v += __builtin_bit_cast(float, __builtin_amdgcn_update_dpp(0, __builtin_bit_cast(int, v), ctrl, rmask, 0xf, true))
            GLA_DPP_ADD(0x111, 0xf); GLA_DPP_ADD(0x112, 0xf); GLA_DPP_ADD(0x114, 0xf); GLA_DPP_ADD(0x118, 0xf);
            asm volatile("s_nop 1\n\tv_add_f32_dpp %0, %0, %0 row_bcast:15 row_mask:0xa bank_mask:0xf\n\ts_nop 1\n\tv_add_f32_dpp %0, %0, %0 row_bcast:31 row_mask:0xc bank_mask:0xf" : "+v"(v));
#undef GLA_DPP_ADD
            bb[p] = v;
        }
#pragma unroll
        for (int g8 = 0; g8 < 4; ++g8) {
            const u32x4 qv = qv4[g8], kv = kv4[g8];
            float qf[8], kf[8], qo[8], ko[8], ebv[8];
#pragma unroll
            for (int i = 0; i < 4; ++i) { qf[2 * i] = bflo(qv[i]); qf[2 * i + 1] = bfhi(qv[i]); kf[2 * i] = bflo(kv[i]); kf[2 * i + 1] = bfhi(kv[i]); }
#pragma unroll
            for (int i = 0; i < 8; ++i) { const int p = 8 * g8 + i;
                const float eb = __expf(bb[p]), inv = __builtin_amdgcn_rcpf(eb);
                const float ebl = __builtin_bit_cast(float, __builtin_amdgcn_readlane(__builtin_bit_cast(int, eb), 63));
                ebv[i] = eb;
                qo[i] = qf[i] * eb * 0.0625f; ko[i] = kf[i] * inv;
                const int pc = P0 + p, R = (pc & ~31) + 16 * ((pc >> 2) & 1) + 4 * ((pc >> 3) & 3) + (pc & 3);
                *(LAS bf16*)(KT + img_off(R, lane, 2)) = (bf16)(cvtpk(ko[i] * ebl, 0.f) & 0xffffu); }
            u32x4 wq, wk;
#pragma unroll
            for (int i = 0; i < 4; ++i) { wq[i] = cvtpk(qo[2 * i], qo[2 * i + 1]); wk[i] = cvtpk(ko[2 * i], ko[2 * i + 1]); }
            *(LAS u32x4*)(QI + img_off(lane, P0 + 8 * g8, 8)) = wq; *(LAS u32x4*)(KI + img_off(lane, P0 + 8 * g8, 8)) = wk;
            if (lane == 63) {
                *(f32x4*)(blob + OFF_DEC + (P0 + 8 * g8) * 4) = (f32x4){ebv[0], ebv[1], ebv[2], ebv[3]}; *(f32x4*)(blob + OFF_DEC + (P0 + 8 * g8 + 4) * 4) = (f32x4){ebv[4], ebv[5], ebv[6], ebv[7]}; }
        }
        asm volatile("s_waitcnt lgkmcnt(0)" ::: "memory"); __builtin_amdgcn_s_barrier(); asm volatile("" ::: "memory");
        { const int tt = wid >> 1, fo = swz((lane & 15) * 64 + (lane >> 4) * 16);
#pragma unroll
          for (int s2 = 0; s2 < 2; ++s2) { const int st = 2 * (wid & 1) + s2; f32x4 d = (f32x4){0.f, 0.f, 0.f, 0.f};
            if (st <= tt) {
                bf16x8 fa_[8], fk_[8]; f32x4 d2 = (f32x4){0.f, 0.f, 0.f, 0.f};
#pragma unroll
                for (int ks = 0; ks < 8; ++ks) { fa_[ks] = *(LAS bf16x8*)(QI + (tt * 8 + ks) * 1024 + fo); fk_[ks] = *(LAS bf16x8*)(KI + (st * 8 + ks) * 1024 + fo); }
                __builtin_amdgcn_sched_barrier(0);
#pragma unroll
                for (int ks = 0; ks < 8; ks += 2) { d = __builtin_amdgcn_mfma_f32_16x16x32_bf16(fa_[ks], fk_[ks], d, 0, 0, 0); d2 = __builtin_amdgcn_mfma_f32_16x16x32_bf16(fa_[ks + 1], fk_[ks + 1], d2, 0, 0, 0); }
                d = d + d2; }
#pragma unroll
            for (int r = 0; r < 4; ++r) { const int t = 16 * tt + 4 * (lane >> 4) + r, s = 16 * st + (lane & 15); *(LAS bf16*)(AI + img_off(t, s, 2)) = (bf16)f2bf(s <= t ? d[r] : 0.f); } } }
        asm volatile("s_waitcnt lgkmcnt(0)" ::: "memory"); __builtin_amdgcn_s_barrier(); asm volatile("" ::: "memory");
        u32x4 vv_[8];
#pragma unroll
        for (int k = 0; k < 8; ++k) { const int piece = k * 512 + tid, t = piece >> 6, ec = piece & 63; vv_[k] = *(const u32x4*)(V + (T0 + t) * 2048 + 512 * h + 8 * ec); }
#pragma unroll
        for (int k = 0; k < 4; ++k) { const int off = k * 8192 + tid * 16; *(u32x4*)(blob + OFF_QI + off) = *(LAS u32x4*)(QI + off); *(u32x4*)(blob + OFF_KT + off) = *(LAS u32x4*)(KT + off); }
        *(u32x4*)(blob + OFF_AI + tid * 16) = *(LAS u32x4*)(AI + tid * 16);
        asm volatile("s_waitcnt lgkmcnt(0)" ::: "memory"); __builtin_amdgcn_s_barrier(); asm volatile("" ::: "memory");
#pragma unroll
        for (int k = 0; k < 8; ++k) { const int piece = k * 512 + tid, t = piece >> 6, ec = piece & 63; *(LAS u32x4*)(lds + t * 1024 + ((ec ^ ((t >> 3) & 7)) * 16)) = vv_[k]; }
        asm volatile("s_waitcnt lgkmcnt(0)" ::: "memory"); __builtin_amdgcn_s_barrier(); asm volatile("" ::: "memory");
#pragma unroll
        for (int kh = 0; kh < 2; ++kh) {
            unsigned short vv[4][8];
#pragma unroll
            for (int k4 = 0; k4 < 4; ++k4) { const int piece = (4 * kh + k4) * 512 + tid, e = piece >> 3, tc = piece & 7, ec = e >> 3;
#pragma unroll
                for (int i = 0; i < 8; ++i) vv[k4][i] = *(LAS bf16*)(lds + (8 * tc + i) * 1024 + ((ec ^ tc) * 16) + (e & 7) * 2); }
            __builtin_amdgcn_sched_barrier(0);
#pragma unroll
            for (int k4 = 0; k4 < 4; ++k4) { const int piece = (4 * kh + k4) * 512 + tid, e = piece >> 3, tc = piece & 7;
                u32x4 w; w.x = vv[k4][0] | ((unsigned)vv[k4][1] << 16); w.y = vv[k4][2] | ((unsigned)vv[k4][3] << 16); w.z = vv[k4][4] | ((unsigned)vv[k4][5] << 16); w.w = vv[k4][6] | ((unsigned)vv[k4][7] << 16);
                *(u32x4*)(VT + (size_t)bi * 32768 + e * 64 + 8 * tc) = w; } }
        asm volatile("s_waitcnt lgkmcnt(0)" ::: "memory"); __builtin_amdgcn_s_barrier(); asm volatile("" ::: "memory");
    }
}

__device__ __forceinline__ void rec(LAS unsigned char* lds, const unsigned char* IMG, const bf16* VT, bf16* O, int wg, int nwg, int wv) {
    const int tid = fresh_tid(wv), lane = tid & 63, wid = __builtin_amdgcn_readfirstlane(tid >> 6), l15 = lane & 15, q = lane >> 4;
    const int fo = swz(l15 * 64 + q * 16);
    for (int item = wg; item < BATCH * GLA_H * 4; item += nwg) {
        const int j = item & 3, h = (item >> 2) & 3, b = item >> 4, E0 = 128 * j + 16 * wid;
        f32x4 S[16];
#pragma unroll
        for (int i = 0; i < 16; ++i) S[i] = (f32x4){0.f, 0.f, 0.f, 0.f};
        const size_t bi0 = (size_t)(b * 32) * 4 + h;
#define GLA_DMA(c_, buf_) do { const unsigned char* src_ = IMG + (bi0 + 4 * (size_t)(c_)) * BLOB; \
        for (int pc_ = wid; pc_ < 73; pc_ += 8) __builtin_amdgcn_global_load_lds((const unsigned*)(src_ + pc_ * 1024 + lane * 16), (LAS unsigned*)((buf_) + pc_ * 1024), 16, 0, 0); } while (0)
#define GLA_VT(c_, dst_) do { const bf16* vp_ = VT + (bi0 + 4 * (size_t)(c_)) * 32768 + (size_t)(E0 + l15) * 64 + 8 * q; dst_[0] = *(const bf16x8*)vp_; dst_[1] = *(const bf16x8*)(vp_ + 32); } while (0)
        bf16x8 vt[2], vtn[2];
        GLA_DMA(0, lds); GLA_VT(0, vt);
        asm volatile("s_waitcnt vmcnt(0)" ::: "memory"); __builtin_amdgcn_s_barrier(); asm volatile("" ::: "memory");
        for (int c = 0; c < 32; ++c) {
            LAS unsigned char* cur = lds + (c & 1) * BLOB; LAS unsigned char* nxt = lds + ((c + 1) & 1) * BLOB;
            vtn[0] = vt[0]; vtn[1] = vt[1];
            if (c + 1 < 32) { GLA_DMA(c + 1, nxt); GLA_VT(c + 1, vtn); }
            bf16x8 Sf[8];
#pragma unroll
            for (int ks = 0; ks < 8; ++ks) { u32x4 w; w.x = cvtpk(S[2 * ks][0], S[2 * ks][1]); w.y = cvtpk(S[2 * ks][2], S[2 * ks][3]); w.z = cvtpk(S[2 * ks + 1][0], S[2 * ks + 1][1]); w.w = cvtpk(S[2 * ks + 1][2], S[2 * ks + 1][3]);
                Sf[ks] = __builtin_bit_cast(bf16x8, w); }
            f32x4 o[4];
#pragma unroll
            for (int tt = 0; tt < 4; ++tt) o[tt] = (f32x4){0.f, 0.f, 0.f, 0.f};
            const LAS unsigned char* fb_ = cur + fo;
            u32x4 F0[8], F1[8];
#define REC_SB() __builtin_amdgcn_sched_barrier(0)
#define REC_LQ(F, kb) do { _Pragma("unroll") for (int j_ = 0; j_ < 8; ++j_) F[j_] = *(const LAS u32x4*)(fb_ + OFF_QI + ((j_ & 3) * 8 + 2 * (kb) + (j_ >> 2)) * 1024); REC_SB(); } while (0)
#define REC_MQ(F, kb) do { _Pragma("unroll") for (int j_ = 0; j_ < 8; ++j_) o[j_ & 3] = __builtin_amdgcn_mfma_f32_16x16x32_bf16(Sf[2 * (kb) + (j_ >> 2)], __builtin_bit_cast(bf16x8, F[j_]), o[j_ & 3], 0, 0, 0); REC_SB(); } while (0)
#define REC_LA(F) do { _Pragma("unroll") for (int j_ = 0; j_ < 8; ++j_) F[j_] = *(const LAS u32x4*)(fb_ + OFF_AI + ((j_ & 3) * 2 + (j_ >> 2)) * 1024); REC_SB(); } while (0)
#define REC_MA(F) do { _Pragma("unroll") for (int j_ = 0; j_ < 8; ++j_) o[j_ & 3] = __builtin_amdgcn_mfma_f32_16x16x32_bf16(vt[j_ >> 2], __builtin_bit_cast(bf16x8, F[j_]), o[j_ & 3], 0, 0, 0); REC_SB(); } while (0)
#define REC_LD(F, d) do { _Pragma("unroll") for (int j_ = 0; j_ < 8; ++j_) { const int i_ = 8 * (d) + j_; F[j_] = *(const LAS u32x4*)(cur + OFF_DEC + (32 * (i_ >> 1) + 8 * q + 4 * (i_ & 1)) * 4); } REC_SB(); } while (0)
#define REC_MD(F, d) do { _Pragma("unroll") for (int j_ = 0; j_ < 8; ++j_) S[8 * (d) + j_] = S[8 * (d) + j_] * __builtin_bit_cast(f32x4, F[j_]); REC_SB(); } while (0)
#define REC_LK(F, n) do { _Pragma("unroll") for (int j_ = 0; j_ < 8; ++j_) F[j_] = *(const LAS u32x4*)(fb_ + OFF_KT + ((8 * ((n) & 1) + j_) * 2 + ((n) >> 1)) * 1024); REC_SB(); } while (0)
#define REC_MK(F, n) do { _Pragma("unroll") for (int j_ = 0; j_ < 8; ++j_) S[8 * ((n) & 1) + j_] = __builtin_amdgcn_mfma_f32_16x16x32_bf16(__builtin_bit_cast(bf16x8, F[j_]), vt[(n) >> 1], S[8 * ((n) & 1) + j_], 0, 0, 0); REC_SB(); } while (0)
            REC_SB();
            REC_LQ(F0, 0);
            REC_LQ(F1, 1); REC_MQ(F0, 0);
            REC_LQ(F0, 2); REC_MQ(F1, 1);
            REC_LQ(F1, 3); REC_MQ(F0, 2);
            REC_LA(F0);    REC_MQ(F1, 3);
            REC_LD(F1, 0); REC_MA(F0);
            { const size_t row0 = (size_t)b * SEQ + 64 * c + l15;
#pragma unroll
              for (int tt = 0; tt < 4; ++tt) { u32x2 w; w.x = cvtpk(o[tt][0], o[tt][1]); w.y = cvtpk(o[tt][2], o[tt][3]); *(u32x2*)(O + (row0 + 16 * tt) * 2048 + 512 * h + E0 + 4 * q) = w; } }
            REC_SB();
            REC_LD(F0, 1); REC_MD(F1, 0);
            REC_LK(F1, 0); REC_MD(F0, 1);
            REC_LK(F0, 1); REC_MK(F1, 0);
            REC_LK(F1, 2); REC_MK(F0, 1);
            REC_LK(F0, 3); REC_MK(F1, 2);
                           REC_MK(F0, 3);
#undef REC_SB
#undef REC_LQ
#undef REC_MQ
#undef REC_LA
#undef REC_MA
#undef REC_LD
#undef REC_MD
#undef REC_LK
#undef REC_MK
            asm volatile("s_waitcnt vmcnt(4) lgkmcnt(0)" ::: "memory"); __builtin_amdgcn_s_barrier(); asm volatile("" ::: "memory");
            vt[0] = vtn[0]; vt[1] = vtn[1];
        }
#undef GLA_DMA
#undef GLA_VT
    }
}
}

namespace swa {
typedef short bf16x8 __attribute__((ext_vector_type(8)));
typedef short s16x4 __attribute__((ext_vector_type(4)));
typedef float f32x16 __attribute__((ext_vector_type(16)));
constexpr int D = 128, NW = 8, QBLK = 32, KVBLK = 64, QB = NW * QBLK, W = 129;
constexpr int SHM_V = KVBLK * D * 2, SHM_K = KVBLK * D * 2;
constexpr int LDS_NEED = 2 * SHM_V + 2 * SHM_K + NW * 64 * 4;
constexpr int OSTG_OFF = 69632, OSTG_PITCH = 272, OSTG_WAVE = 32 * OSTG_PITCH;
static_assert(OSTG_OFF >= LDS_NEED && OSTG_OFF + NW * OSTG_WAVE <= 155648 - 256, "O staging inside the workgroup's LDS, clear of the control words");
constexpr float SCALE = 0.08838834764831845f, THR = 8.f;
constexpr int RS = DIL_IN, ORS = DIL_WIDTH, LRS = DIL_HEADS;
constexpr bool SK = true;
#define KSWZ(row, colB) ((row) * 256 + ((colB) ^ (((row) & 7) << 4)))
#define SBAR() __builtin_amdgcn_sched_barrier(0)
__device__ __forceinline__ int v_st(int k, int c) { const int kk = (k & ~0xC) | ((k & 4) << 1) | ((k & 8) >> 1); return ((kk >> 3) * 4 + (c >> 5)) * 512 + ((kk & 7) * 32 + (c & 31)) * 2; }
__device__ __forceinline__ int v_rd_base(int lane) { return ((lane & 3) << 3) | (((lane >> 2) & 3) << 6) | (((lane >> 4) & 1) << 5) | (((lane >> 5) & 1) << 8); }
constexpr int v_rd_off(int d0, int ks, int half) { return d0 * 512 + ks * 4096 + half * 2048; }
__device__ __forceinline__ int crow(int r, int hi) { return (r & 3) + 8 * (r >> 2) + 4 * hi; }
__device__ __forceinline__ unsigned cvtpk(float lo, float hi) { unsigned r; asm volatile("v_cvt_pk_bf16_f32 %0, %1, %2" : "=v"(r) : "v"(lo), "v"(hi)); return r; }
__device__ __forceinline__ bf16x8 load8(const bf16* p) { return *reinterpret_cast<const bf16x8*>(p); }
__device__ __forceinline__ void mask_tile(f32x16& p0, f32x16& p1, int dq, unsigned Wl) {
    const float NEG = -__builtin_inff();
#pragma unroll
    for (int r = 0; r < 16; ++r) { const int c = (r & 3) + 8 * (r >> 2);
        if ((unsigned)(dq - c) >= Wl) p0[r] = NEG;
        if ((unsigned)(dq - c - 32) >= Wl) p1[r] = NEG; }
}
__device__ __forceinline__ void partialSM(f32x16& p0, f32x16& p1, float& m_reg, float& mn, float& alpha) {
    float pmax = p0[0]; for (int r = 1; r < 16; ++r) pmax = fmaxf(pmax, p0[r]); for (int r = 0; r < 16; ++r) pmax = fmaxf(pmax, p1[r]);
    { auto rr = __builtin_amdgcn_permlane32_swap(__float_as_uint(pmax), __float_as_uint(pmax), false, false);
      pmax = fmaxf(__uint_as_float(rr[0]), __uint_as_float(rr[1])); }
    constexpr float C2 = 1.4426950408889634f * SCALE;
    if (__builtin_expect(__all((pmax - m_reg) * SCALE <= THR), 1)) { mn = m_reg; alpha = 1.f; }
    else { mn = fmaxf(m_reg, pmax); alpha = __builtin_amdgcn_exp2f((m_reg - mn) * C2); m_reg = mn; }
    const float mnL = -mn * C2;
    for (int r = 0; r < 16; ++r) p0[r] = fmaf(p0[r], C2, mnL); for (int r = 0; r < 16; ++r) p1[r] = fmaf(p1[r], C2, mnL);
    for (int r = 0; r < 16; ++r) p0[r] = __builtin_amdgcn_exp2f(p0[r]);
}
__device__ __forceinline__ void finishSM(f32x16& p0, f32x16& p1, float alpha, float& l_reg, bf16x8& pa0, bf16x8& pa1, bf16x8& pa2, bf16x8& pa3) {
    for (int r = 0; r < 16; ++r) p1[r] = __builtin_amdgcn_exp2f(p1[r]);
    float ps = 0; for (int r = 0; r < 16; ++r) ps += p0[r]; for (int r = 0; r < 16; ++r) ps += p1[r];
    { auto rr = __builtin_amdgcn_permlane32_swap(__float_as_uint(ps), __float_as_uint(ps), false, false);
      ps = __uint_as_float(rr[0]) + __uint_as_float(rr[1]); }
    l_reg = l_reg * alpha + ps;
#define PK4(P, B_, OUT) do { unsigned a0 = cvtpk(P[B_+0], P[B_+1]), a1 = cvtpk(P[B_+2], P[B_+3]);                          \
        unsigned b0 = cvtpk(P[B_+4], P[B_+5]), b1 = cvtpk(P[B_+6], P[B_+7]);                                             \
        auto r0 = __builtin_amdgcn_permlane32_swap(a0, b0, false, false); auto r1 = __builtin_amdgcn_permlane32_swap(a1, b1, false, false); \
        u32x4 w = {r0[0], r1[0], r0[1], r1[1]}; OUT = *reinterpret_cast<bf16x8*>(&w); } while (0)
    PK4(p0, 0, pa0); PK4(p0, 8, pa1); PK4(p1, 0, pa2); PK4(p1, 8, pa3);
#undef PK4
}
template <int KB>
__device__ __forceinline__ void qkt(f32x16& p0, f32x16& p1, const char* K_lds, int r32, int hi, const bf16x8* qr, bool act) {
    if (SK && !act) { const float NEG = -__builtin_inff();
#pragma unroll
        for (int r = 0; r < 16; ++r) { p0[r] = NEG; p1[r] = NEG; } return; }
    p0 = f32x16{}; p1 = f32x16{};
    const char* kb[4];
#pragma unroll
    for (int dd = 0; dd < 4; ++dd) kb[dd] = K_lds + KB * SHM_K + KSWZ(r32, (dd * 16 + hi * 8) * 2);
#define QKT_LD(x, y, d0) do { const char* a_ = kb[(d0) & 3] + ((d0) >> 2) * 128; x = *reinterpret_cast<const bf16x8*>(a_); y = *reinterpret_cast<const bf16x8*>(a_ + 32 * 256); } while (0)
#define QKT_MM(x, y, d0) do { p0 = __builtin_amdgcn_mfma_f32_32x32x16_bf16(x, qr[d0], p0, 0, 0, 0); p1 = __builtin_amdgcn_mfma_f32_32x32x16_bf16(y, qr[d0], p1, 0, 0, 0); } while (0)
    bf16x8 xa, ya, xb, yb, xc, yc;
    QKT_LD(xa, ya, 0); QKT_LD(xb, yb, 1); SBAR();
    QKT_LD(xc, yc, 2); SBAR(); QKT_MM(xa, ya, 0); SBAR();
    QKT_LD(xa, ya, 3); SBAR(); QKT_MM(xb, yb, 1); SBAR();
    QKT_LD(xb, yb, 4); SBAR(); QKT_MM(xc, yc, 2); SBAR();
    QKT_LD(xc, yc, 5); SBAR(); QKT_MM(xa, ya, 3); SBAR();
    QKT_LD(xa, ya, 6); SBAR(); QKT_MM(xb, yb, 4); SBAR();
    QKT_LD(xb, yb, 7); SBAR(); QKT_MM(xc, yc, 5); SBAR();
    QKT_MM(xa, ya, 6); SBAR(); QKT_MM(xb, yb, 7); SBAR();
#undef QKT_LD
#undef QKT_MM
}
template <int VB>
__device__ __forceinline__ void pv_tile(f32x16* o, int vb0, bf16x8 pa0, bf16x8 pa1, bf16x8 pa2, bf16x8 pa3, bool act) {
    if (SK && !act) return;
#define TRRD(dst, off) asm volatile("ds_read_b64_tr_b16 %0, %1 offset:%2" : "=&v"(dst) : "v"(vb0), "i"(off) : "memory")
#define PV_D0(d0) do { s16x4 l0, l1, l2, l3, h0, h1, h2, h3; constexpr int b_ = VB * SHM_V + v_rd_off(d0, 0, 0); \
        TRRD(l0, b_); TRRD(h0, b_ + 2048); TRRD(l1, b_ + 4096); TRRD(h1, b_ + 6144); TRRD(l2, b_ + 8192); TRRD(h2, b_ + 10240); TRRD(l3, b_ + 12288); TRRD(h3, b_ + 14336); \
        asm volatile("s_waitcnt lgkmcnt(0)" ::: "memory"); SBAR();   \
        o[d0] = __builtin_amdgcn_mfma_f32_32x32x16_bf16(pa0, (bf16x8){l0[0], l0[1], l0[2], l0[3], h0[0], h0[1], h0[2], h0[3]}, o[d0], 0, 0, 0);   \
        o[d0] = __builtin_amdgcn_mfma_f32_32x32x16_bf16(pa1, (bf16x8){l1[0], l1[1], l1[2], l1[3], h1[0], h1[1], h1[2], h1[3]}, o[d0], 0, 0, 0);   \
        o[d0] = __builtin_amdgcn_mfma_f32_32x32x16_bf16(pa2, (bf16x8){l2[0], l2[1], l2[2], l2[3], h2[0], h2[1], h2[2], h2[3]}, o[d0], 0, 0, 0);   \
        o[d0] = __builtin_amdgcn_mfma_f32_32x32x16_bf16(pa3, (bf16x8){l3[0], l3[1], l3[2], l3[3], h3[0], h3[1], h3[2], h3[3]}, o[d0], 0, 0, 0); } while (0)
    PV_D0(0); PV_D0(1); PV_D0(2); PV_D0(3);
#undef PV_D0
#undef TRRD
}
struct BlockRef { const bf16* Q; const bf16* K; const bf16* V; bf16* O; float* L; int P0, sh, msk, dil, segmask, skv; };
struct Seam { bf16x8 qr[8]; bf16x8 st_v0, st_v1, st_k0, st_k1; };
__device__ __forceinline__ int rowoff(const BlockRef& r, int pos) { return (pos >> r.sh) + (pos & r.msk) * r.dil; }
__device__ __forceinline__ int swa_jlo(int P0) { const int lowk = P0 - W + 1; return lowk > 0 ? lowk / KVBLK : 0; }
#define VMW() asm volatile("s_waitcnt vmcnt(0)" ::: "memory")
#define VMWN(n) asm volatile("s_waitcnt vmcnt(%0)" :: "i"(n) : "memory")
#define SLOAD_H(ref, k0) do { const size_t r0_ = (size_t)rowoff(ref, (k0) + sr) * RS + sc, r1_ = (size_t)rowoff(ref, (k0) + 32 + sr) * RS + sc; \
                         S.st_v0 = load8((ref).V + r0_); S.st_v1 = load8((ref).V + r1_); S.st_k0 = load8((ref).K + r0_); S.st_k1 = load8((ref).K + r1_); } while (0)
#define SWRITE_HK(bf) do { *(bf16x8*)(K_lds + (bf) * SHM_K + kws) = S.st_k0; *(bf16x8*)(K_lds + (bf) * SHM_K + kws + 32 * 256) = S.st_k1; } while (0)
#define SWRITE_HV(bf) do { *(bf16x8*)(V_lds + (bf) * SHM_V + vst0) = S.st_v0; *(bf16x8*)(V_lds + (bf) * SHM_V + vst1) = S.st_v1; } while (0)
#define SWRITE_H(bf) do { SWRITE_HV(bf); SWRITE_HK(bf); } while (0)
__device__ __forceinline__ void prime(const BlockRef& cur, char* lds, Seam& S, int wv) {
    const int tid = fresh_tid(wv), wid = __builtin_amdgcn_readfirstlane(tid >> 6), lane = tid & 63, r32 = lane & 31, hi = lane >> 5;
    const int sr = tid >> 4, sc = (tid & 15) * 8, kws = KSWZ(sr, sc * 2); char* K_lds = lds + 2 * SHM_V;
    const int kb0 = swa_jlo(cur.P0) * KVBLK;
    const bf16* qrow = cur.Q + (size_t)rowoff(cur, cur.P0 + wid * QBLK + r32) * RS;
    for (int d0 = 0; d0 < 8; ++d0) S.qr[d0] = load8(qrow + d0 * 16 + hi * 8);
    SLOAD_H(cur, kb0); VMW(); SWRITE_HK(0);
    __syncthreads();
}
__device__ __forceinline__ void block(const BlockRef& cur, const BlockRef& nxt, char* lds, Seam& S, int wv) {
    const int tid = fresh_tid(wv), wid = __builtin_amdgcn_readfirstlane(tid >> 6), lane = tid & 63, r32 = lane & 31, hi = lane >> 5;
    const int j_lo = swa_jlo(cur.P0);
    int j_hi = (cur.P0 + QB - 1) / KVBLK + 1; if (j_hi > cur.skv / KVBLK) j_hi = cur.skv / KVBLK;
    const int NT = j_hi - j_lo;
    const int kbn = swa_jlo(nxt.P0) * KVBLK;
    const int qlo = cur.P0 + wid * QBLK, qm = qlo + r32 - 4 * hi;
    const int segst = qlo & ~cur.segmask;
    const int lowk = (qlo - W + 1) > segst ? (qlo - W + 1) : segst;
    const unsigned Wl = (unsigned)((((qlo + r32) & cur.segmask) + 1) < W ? (((qlo + r32) & cur.segmask) + 1) : W);
    char* V_lds = lds; char* K_lds = lds + 2 * SHM_V;
    float* ws = (float*)(lds + 2 * SHM_V + 2 * SHM_K) + wid * 64; float* li_l = ws, * al_l = ws + 32;
    float m_reg = -1e30f, l_reg = 0; f32x16 o[4] = {};
    const int sr = tid >> 4, sc = (tid & 15) * 8, vst0 = v_st(sr, sc), vst1 = v_st(32 + sr, sc), kws = KSWZ(sr, sc * 2);
    const int vb0 = (int)(uintptr_t)V_lds + v_rd_base(lane);
#define RESC(a) do { if (__any((a) < 1.f)) { if (hi == 0) al_l[r32] = (a); asm volatile("s_waitcnt lgkmcnt(0)" ::: "memory");              \
                     for (int d_ = 0; d_ < 4; ++d_) for (int r = 0; r < 16; ++r) o[d_][r] *= al_l[crow(r, hi)]; } } while (0)
#define KBASE(t) ((j_lo + (t)) * KVBLK)
#define ACT(t) (KBASE(t) <= qlo + QBLK - 1 && KBASE(t) + KVBLK - 1 >= lowk)
#define MASKT(P0_, P1_, t) do { const int kb_ = KBASE(t); if ((!SK || ACT(t)) && (kb_ + KVBLK - 1 > qlo || kb_ <= qlo + QBLK - 1 - W || kb_ < segst)) mask_tile(P0_, P1_, qm - kb_, Wl); } while (0)
    constexpr int NQL = 8;
#define SEAM_K0() do { VMWN(NQL); SWRITE_HK(0); SBAR(); } while (0)
    f32x16 pA0, pA1, pB0, pB1; float mnA, mnB, alA, alB; bf16x8 pa0, pa1, pa2, pa3;
    SWRITE_HV(0); SBAR();
    if (NT > 1) { SLOAD_H(cur, KBASE(1)); }
    SBAR(); qkt<0>(pA0, pA1, K_lds, r32, hi, S.qr, ACT(0));
    MASKT(pA0, pA1, 0); partialSM(pA0, pA1, m_reg, mnA, alA);
    if (NT > 1) { VMW(); SWRITE_H(1); }
    __syncthreads();
#define HALF_STEP(PX0, PX1, mnX, alX, PY0, PY1, alY, t, KB, VB, SB) do {                                                      \
        SBAR(); qkt<KB>(PX0, PX1, K_lds, r32, hi, S.qr, ACT(t));                                             \
        finishSM(PY0, PY1, alY, l_reg, pa0, pa1, pa2, pa3); SBAR();                                                           \
        if ((t) + 1 < NT) { SLOAD_H(cur, KBASE((t) + 1)); SBAR(); }                                               \
        pv_tile<VB>(o, vb0, pa0, pa1, pa2, pa3, ACT((t) - 1)); MASKT(PX0, PX1, (t)); partialSM(PX0, PX1, m_reg, mnX, alX);                                        \
        __syncthreads();                                                                                                      \
        if ((t) + 1 < NT) { VMW(); SWRITE_H(SB); }                                                                          \
        RESC(alX); __syncthreads(); } while (0)
    for (int t = 1; t + 1 < NT; t += 2) {
        HALF_STEP(pB0, pB1, mnB, alB, pA0, pA1, alA, t, 1, 0, 0);
        HALF_STEP(pA0, pA1, mnA, alA, pB0, pB1, alB, t + 1, 0, 1, 1);
    }
    const bool even = (NT & 1) == 0;
    if (even) { SBAR(); qkt<1>(pB0, pB1, K_lds, r32, hi, S.qr, ACT(NT - 1)); SBAR(); }
    { SLOAD_H(nxt, kbn); SBAR();
      const bf16* qrow = nxt.Q + (size_t)rowoff(nxt, nxt.P0 + wid * QBLK + r32) * RS;
#pragma unroll
      for (int d0 = 0; d0 < 8; ++d0) S.qr[d0] = load8(qrow + d0 * 16 + hi * 8); }
    SBAR();
    finishSM(pA0, pA1, alA, l_reg, pa0, pa1, pa2, pa3); SBAR();
    pv_tile<0>(o, vb0, pa0, pa1, pa2, pa3, ACT(even ? NT - 2 : NT - 1));
    if (even) { MASKT(pB0, pB1, NT - 1); partialSM(pB0, pB1, m_reg, mnB, alB); __syncthreads(); RESC(alB);
        finishSM(pB0, pB1, alB, l_reg, pa0, pa1, pa2, pa3); SBAR(); pv_tile<1>(o, vb0, pa0, pa1, pa2, pa3, ACT(NT - 1)); }
    SBAR(); SEAM_K0();
    if (hi == 0) { li_l[r32] = l_reg; cur.L[(size_t)rowoff(cur, qlo + r32) * LRS] = m_reg * (1.4426950408889634f * SCALE) + __log2f(l_reg); }
    asm volatile("s_waitcnt lgkmcnt(0)" ::: "memory");
    float rli[16];
#pragma unroll
    for (int r = 0; r < 16; ++r) rli[r] = __builtin_amdgcn_rcpf(li_l[crow(r, hi)]);
    { char* stg = lds + OSTG_OFF + wid * OSTG_WAVE;
#pragma unroll
      for (int r = 0; r < 16; ++r) { char* rp = stg + crow(r, hi) * OSTG_PITCH + r32 * 2;
#pragma unroll
          for (int d0 = 0; d0 < 4; ++d0) *(unsigned short*)(rp + d0 * 64) = (unsigned short)cvtpk(o[d0][r] * rli[r], 0.f); }
      asm volatile("s_waitcnt lgkmcnt(0)" ::: "memory");
#pragma unroll
      for (int k = 0; k < 8; ++k) { const int row = 4 * k + (lane >> 4), ch = lane & 15;
          const u32x4 v = *(const u32x4*)(stg + row * OSTG_PITCH + ch * 16);
          *(u32x4*)(cur.O + (size_t)rowoff(cur, qlo + row) * ORS + ch * 8) = v; } }
    asm volatile("s_waitcnt lgkmcnt(0)" ::: "memory"); __syncthreads();
#undef RESC
#undef KBASE
#undef ACT
#undef MASKT
#undef SEAM_K0
#undef HALF_STEP
}
#undef VMW
#undef VMWN
#undef SLOAD_H
#undef SWRITE_HK
#undef SWRITE_HV
#undef SWRITE_H
__device__ __forceinline__ BlockRef decode(int L, const bf16* PROJ, bf16* OG, float* LSE) {
    const int g = L >> 10, idx = L & 1023, b = idx >> 6; BlockRef r; int base, h;
    if (g == 0) { h = (idx >> 3) & 7; const int qb = ((idx & 7) + (idx >> 8)) & 7; base = b * SEQ; r.P0 = QB * qb; r.sh = 30; r.msk = 0x3fffffff; r.dil = 1; r.segmask = 0x7fffffff; r.skv = 2048; }
    else if (g == 1) { const int res = (idx >> 4) & 3; h = (idx >> 1) & 7; base = b * SEQ + res; r.P0 = QB * ((idx ^ (idx >> 8)) & 1); r.sh = 30; r.msk = 0x3fffffff; r.dil = 4; r.segmask = 0x7fffffff; r.skv = 512; }
    else { const int pair = (idx >> 3) & 7; h = idx & 7; base = b * SEQ + 2 * pair; r.P0 = 0; r.sh = 7; r.msk = 127; r.dil = 16; r.segmask = 127; r.skv = 256; }
    r.Q = PROJ + (size_t)base * RS + g * 3072 + h * 128; r.K = r.Q + 1024; r.V = r.Q + 2048;
    r.O = OG + (size_t)g * MTOK * ORS + (size_t)base * ORS + h * 128; r.L = LSE + (size_t)g * MTOK * LRS + (size_t)base * LRS + h;
    return r;
}
__device__ __forceinline__ void phase(char* lds, const bf16* PROJ, bf16* OG, float* LSE, int wg, int nwg, int wv) {
    constexpr int total = 3 * 1024;
    int L = wg; if (L >= total) return;
    BlockRef cur = decode(L, PROJ, OG, LSE);
    Seam S;
    prime(cur, lds, S, wv);
    for (;;) {
        const bool more = L + nwg < total;
        const BlockRef nxt = more ? decode(L + nwg, PROJ, OG, LSE) : cur;
        block(cur, nxt, lds, S, wv);
        if (!more) break;
        cur = nxt; L += nwg;
    }
}
#undef KSWZ
#undef SBAR
}

__device__ __forceinline__ void ffn_fixup(const float* HALO, bf16* ACT, const float* cw, const float* cb, int gt, int ngt) {
    for (int idx = gt; idx < (MTOK / 256) * DFF; idx += ngt) {
        const int pm = idx / DFF, c = idx % DFF, sg = 256 * (c / 128) + (c % 128);
        const float* h = HALO + (size_t)pm * 4 * NUP;
        const bool first = (pm & 7) == 0;
        float res[2][2];
#pragma unroll
        for (int bj = 0; bj < 2; ++bj) {
            const int col = bj * DFF + c, s = sg + 128 * bj;
            const float w0 = cw[col], w1 = cw[NUP + col], w2 = cw[2 * NUP + col], bb = cb[col];
            const float p2 = first ? 0.f : h[-2 * NUP + s], p1 = first ? 0.f : h[-1 * NUP + s], h0 = h[s], h1 = h[NUP + s];
            res[bj][0] = w0 * p2 + w1 * p1 + w2 * h0 + bb; res[bj][1] = w0 * p1 + w1 * h0 + w2 * h1 + bb;
        }
#pragma unroll
        for (int r = 0; r < 2; ++r) { const float g = res[0][r]; ACT[(size_t)(pm * 256 + r) * DFF + c] = (bf16)f2bf(g / (1.f + __expf(-g)) * res[1][r]); }
    }
}

#define XB_TMO      128
#define XB_XCNT(j)  (256  + 64 * (j))
#define XB_XSUB(j)  (1280 + 64 * (j))
#define XB_XGEN(j)  (2304 + 64 * (j))
#define XB_TOP      3328
#define XB_TOPGEN   3392
#define XCD_BAR_WORDS 3456
#define XB_SPIN_CAP (1u << 18)
__device__ __forceinline__ unsigned xb_ld(unsigned* p)              { return __hip_atomic_load(p, __ATOMIC_RELAXED, __HIP_MEMORY_SCOPE_AGENT); }
__device__ __forceinline__ unsigned xb_add(unsigned* p, unsigned v) { return __hip_atomic_fetch_add(p, v, __ATOMIC_RELAXED, __HIP_MEMORY_SCOPE_AGENT); }
__device__ __forceinline__ unsigned xb_xcc_id() { return (unsigned)__builtin_amdgcn_s_getreg((3 << 11) | 20) & 0xFu; }
#define XB_SPIN(cond, bar) do { unsigned _sp = 0; while (cond) { __builtin_amdgcn_s_sleep(1); \
    if ((++_sp & 255u) == 0u) { if (xb_ld(&(bar)[XB_TMO])) break; if (_sp > XB_SPIN_CAP) { atomicAdd(&(bar)[XB_TMO], 1u); break; } } } } while (0)
struct XcdBarrier { unsigned* bar; unsigned x; volatile LAS unsigned* st; };
__device__ __forceinline__ XcdBarrier xcd_barrier_post(unsigned* bar, volatile LAS unsigned* st) {
    XcdBarrier b; b.bar = bar; b.x = xb_xcc_id(); b.st = st;
    if (threadIdx.x == 0) (void)xb_add(&bar[XB_XCNT(b.x)], 1u);
    return b;
}
__device__ __forceinline__ void xcd_barrier_complete(unsigned* bar, unsigned x, unsigned& nloc, unsigned& nx) {
    const unsigned G = gridDim.x * gridDim.y * gridDim.z;
    unsigned sum, cnt, mine, sp = 0u;
    for (;;) {
        sum = 0u; cnt = 0u; mine = 0u;
#pragma unroll
        for (unsigned j = 0; j < 16; ++j) { const unsigned c = xb_ld(&bar[XB_XCNT(j)]); sum += c; cnt += (c > 0u) ? 1u : 0u; mine = (j == x) ? c : mine; }
        if (sum == G) break;
        __builtin_amdgcn_s_sleep(1);
        if ((++sp & 255u) == 0u) { if (xb_ld(&bar[XB_TMO])) break; if (sp > XB_SPIN_CAP) { atomicAdd(&bar[XB_TMO], 1u); break; } }
    }
    nloc = mine > 0u ? mine : 1u; nx = cnt > 0u ? cnt : 1u;
}
__device__ __forceinline__ void xcd_barrier(const XcdBarrier& b, int wv) {
    asm volatile("s_waitcnt vmcnt(0)" ::: "memory");
    __syncthreads();
    if (fresh_tid(wv) == 0) {
        unsigned* bar = b.bar;
        __builtin_amdgcn_s_waitcnt(0);
        unsigned nloc = b.st[0], nx = b.st[1];
        if (nloc == 0u) { xcd_barrier_complete(bar, b.x, nloc, nx); b.st[0] = nloc; b.st[1] = nx; }
        const unsigned old = xb_add(&bar[XB_XSUB(b.x)], 1u);
        const unsigned gen = old / nloc;
        if (old + 1u == (gen + 1u) * nloc) {
            __builtin_amdgcn_fence(__ATOMIC_RELEASE, "agent");
            asm volatile("s_waitcnt vmcnt(0)" ::: "memory");
            const unsigned og = xb_add(&bar[XB_TOP], 1u);
            const unsigned tg = og / nx;
            if (og + 1u == (tg + 1u) * nx) xb_add(&bar[XB_TOPGEN], 1u);
            else XB_SPIN(xb_ld(&bar[XB_TOPGEN]) == tg, bar);
            __builtin_amdgcn_fence(__ATOMIC_ACQUIRE, "agent");
            xb_add(&bar[XB_XGEN(b.x)], 1u);
            asm volatile("s_waitcnt vmcnt(0)" ::: "memory");
        } else {
            XB_SPIN(xb_ld(&bar[XB_XGEN(b.x)]) == gen, bar);
            __builtin_amdgcn_fence(__ATOMIC_ACQUIRE, "agent");
            asm volatile("s_waitcnt vmcnt(0)" ::: "memory");
        }
    }
    __syncthreads();
}

constexpr int LDS_BYTES = 155648, MISC_OFF = LDS_BYTES - 256, N_PHASES = 41;
constexpr int CW_BAR = 4096;
constexpr size_t CTL_ZERO_BYTES = 65536;
#ifndef MK_CUTS
#define MK_CUTS 0
#endif
struct Args { Params P; int ph_lo, ph_hi; };
#define REP_PRO 1
#define REP_GIN 1
#define REP_PREP 1
#define REP_REC 1
#define REP_GN 1
#define REP_OUT 1
#define REP_SWA 1
#define REP_COMB 1
#define REP_LN 1
#define REP_UP 1
#define REP_FIX 1
#define REP_DOWN 1
constexpr size_t WS_DUMMY = WS_REG + 400 * MiB;
typedef const __attribute__((address_space(4))) Args* KArgs;
#define KARGS(ap) KArgs ap = (KArgs)__builtin_amdgcn_kernarg_segment_ptr(); asm volatile("" : "+s"(ap))
__global__ void __launch_bounds__(512, 2) mega(Args a) {
    extern __shared__ __attribute__((aligned(16))) unsigned char lds_raw[];
    LAS unsigned char* lds = (LAS unsigned char*)lds_raw;
    const int G = (int)gridDim.x, bx = (int)blockIdx.x, wv = __builtin_amdgcn_readfirstlane((int)threadIdx.x >> 6);
    volatile LAS unsigned* MISC = (volatile LAS unsigned*)(lds + MISC_OFF);
    if (threadIdx.x < 64) MISC[threadIdx.x] = 0u;
    __syncthreads();
    const int lo = a.ph_lo, hi = a.ph_hi; (void)lo; (void)hi;
    if (!MK_CUTS || hi - lo > 1) (void)xcd_barrier_post((unsigned*)(a.P.ws + WS_CTL) + CW_BAR, MISC + 8);
#if MK_CUTS
#define IN(k) (lo <= (k) && (k) < hi)
#else
#define IN(k) true
#endif
#define SEAM(k, kn) do { if (IN(k) && IN(kn)) { KARGS(apb_); XcdBarrier b_; b_.bar = (unsigned*)(apb_->P.ws + WS_CTL) + CW_BAR; b_.x = xb_xcc_id(); b_.st = MISC + 8; xcd_barrier(b_, wv); } } while (0)
#define THIN_IDS() const int tid_ = fresh_tid(wv), lane = tid_ & 63, gw = bx * 8 + (tid_ >> 6), ngw = G * 8
    if (IN(0)) for (int rep_ = 0; rep_ < REP_PRO; ++rep_) { KARGS(ap); Params P;
        P.x = ap->P.x; P.gla_w_in = ap->P.gla_w_in; P.gla_wgu = ap->P.gla_wgu; P.gla_gbias = ap->P.gla_gbias; P.gla_norm_g = ap->P.gla_norm_g; P.gla_w_out = ap->P.gla_w_out; P.dil_w_in = ap->P.dil_w_in; P.dil_w_out = ap->P.dil_w_out;
        P.ffn_w_up = ap->P.ffn_w_up; P.conv_w = ap->P.conv_w; P.conv_b = ap->P.conv_b; P.ffn_w_down = ap->P.ffn_w_down; P.ln_g = ap->P.ln_g; P.ln_b = ap->P.ln_b; P.out = ap->P.out; P.ws = ap->P.ws;
        prologue(P, lds, bx, G, wv); }
    SEAM(0, 1);
    for (int i = 0; i < DEPTH; ++i) {
        const int j = i >> 1, pb = 1 + 10 * i;
        if ((i & 1) == 0) {
            if (IN(pb)) for (int rep_ = 0; rep_ < REP_GIN; ++rep_) { KARGS(ap); unsigned char* ws = ap->P.ws;
                pg8::Gemm g{(const bf16*)ap->P.out, (const bf16*)(ws + WS_WGI) + (size_t)j * GLA_NPAD * DM, MTOK, GLA_NPAD, DM, DM, DM, 0};
                pg8::StaticOrder S; S.init(MTOK, GLA_NPAD, G, bx);
                pg8::EpiGlaIn E{(bf16*)(ws + WS_QK), (float*)(ws + WS_GLOW), (size_t)(WS_V - WS_QK) / 2};
                static_assert(WS_R - WS_V == WS_V - WS_QK, "q|k, v, r tensors equally spaced");
                pg8::gemm_phase<pg8::EpiGlaIn, pg8::StaticOrder, true, true>(lds, g, S, E, wv); }
            SEAM(pb, pb + 1);
            if (IN(pb + 1)) for (int rep_ = 0; rep_ < REP_PREP; ++rep_) { KARGS(ap); unsigned char* ws = ap->P.ws;
                gla::prep(lds, (const bf16*)(ws + WS_QK), (const bf16*)(ws + WS_V), (const float*)(ws + WS_GLOW), ap->P.gla_wgu + (size_t)j * GLA_RANK * GLA_DK, ap->P.gla_gbias + (size_t)j * GLA_DK, ws + WS_IMG, (bf16*)(ws + WS_VT), bx, G, wv); }
            SEAM(pb + 1, pb + 2);
            if (IN(pb + 2)) for (int rep_ = 0; rep_ < REP_REC; ++rep_) { KARGS(ap); unsigned char* ws = ap->P.ws;
                const int vcu = (G % 8 == 0) ? (bx % 8) * (G / 8) + bx / 8 : bx;
                gla::rec(lds, ws + WS_IMG, (const bf16*)(ws + WS_VT), (bf16*)(ws + WS_O), vcu, G, wv); }
            SEAM(pb + 2, pb + 3);
            if (IN(pb + 3)) for (int rep_ = REP_GN - 1; rep_ >= 0; --rep_) { KARGS(ap); unsigned char* ws = ap->P.ws; THIN_IDS();
                gatenorm_rows((const bf16*)(ws + WS_O), (bf16*)(ws + (rep_ ? WS_DUMMY : WS_O)), (const bf16*)(ws + WS_R), ap->P.gla_norm_g + (size_t)j * GLA_HV, gw, ngw, lane); }
            SEAM(pb + 3, pb + 4);
            if (IN(pb + 4)) for (int rep_ = REP_OUT - 1; rep_ >= 0; --rep_) { KARGS(ap); unsigned char* ws = ap->P.ws;
                pg8::Gemm g{(const bf16*)(ws + WS_O), (const bf16*)(ws + WS_WGO) + (size_t)j * DM * GLA_DV, MTOK, DM, GLA_DV, GLA_DV, GLA_DV, 0};
                pg8::StaticOrder S; S.init(MTOK, DM, G, bx);
                pg8::EpiRes E{ap->P.x, (short*)(ws + WS_YQ), (const float*)(ws + WS_STATS), ap->P.ln_g + (size_t)(2 * i - 1) * DM, ap->P.ln_b + (size_t)(2 * i - 1) * DM, ALPHA, i == 0 ? 0 : 1};
                pg8::gemm_phase<pg8::EpiRes, pg8::StaticOrder, true, true>(lds, g, S, E, wv); }
        } else {
            if (IN(pb)) for (int rep_ = 0; rep_ < REP_GIN; ++rep_) { KARGS(ap); unsigned char* ws = ap->P.ws;
                pg8::Gemm g{(const bf16*)ap->P.out, (const bf16*)(ws + WS_WDI) + (size_t)j * DIL_IN * DM, MTOK, DIL_IN, DM, DM, DM, 0};
                pg8::StaticOrder S; S.init(MTOK, DIL_IN, G, bx);
                pg8::EpiBf16Plain E{(bf16*)(ws + WS_PROJ), DIL_IN, 0};
                pg8::gemm_phase<pg8::EpiBf16Plain, pg8::StaticOrder, true, true>(lds, g, S, E, wv); }
            SEAM(pb, pb + 1);
            if (IN(pb + 1)) for (int rep_ = 0; rep_ < REP_SWA; ++rep_) { KARGS(ap); unsigned char* ws = ap->P.ws;
                swa::phase((char*)lds_raw, (const bf16*)(ws + WS_PROJ), (bf16*)(ws + WS_OG), (float*)(ws + WS_LSE), bx, G, wv); }
            SEAM(pb + 1, pb + 2);
            if (IN(pb + 2)) for (int rep_ = REP_COMB - 1; rep_ >= 0; --rep_) { KARGS(ap); unsigned char* ws = ap->P.ws; THIN_IDS();
                combine_rows((const bf16*)(ws + WS_OG), (bf16*)(ws + (rep_ ? WS_REG : WS_OG)), (const float*)(ws + WS_LSE), gw, ngw, lane); }
            SEAM(pb + 2, pb + 4);
            if (IN(pb + 4)) for (int rep_ = REP_OUT - 1; rep_ >= 0; --rep_) { KARGS(ap); unsigned char* ws = ap->P.ws;
                pg8::Gemm g{(const bf16*)(ws + WS_OG), (const bf16*)(ws + WS_WDO) + (size_t)j * DM * DIL_WIDTH, MTOK, DM, DIL_WIDTH, DIL_WIDTH, DIL_WIDTH, 0};
                pg8::StaticOrder S; S.init(MTOK, DM, G, bx);
                pg8::EpiRes E{nullptr, (short*)(ws + WS_YQ), (const float*)(ws + WS_STATS), ap->P.ln_g + (size_t)(2 * i - 1) * DM, ap->P.ln_b + (size_t)(2 * i - 1) * DM, ALPHA, 1};
                pg8::gemm_phase<pg8::EpiRes, pg8::StaticOrder, true, true>(lds, g, S, E, wv); }
        }
        SEAM(pb + 4, pb + 5);
        if (IN(pb + 5)) for (int rep_ = REP_LN - 1; rep_ >= 0; --rep_) { KARGS(ap); unsigned char* ws = ap->P.ws; THIN_IDS();
            ln_rows<false>((const short*)(ws + WS_YQ), nullptr, (bf16*)ap->P.out, (float*)(ws + WS_STATS), ap->P.ln_g + (size_t)(2 * i) * DM, ap->P.ln_b + (size_t)(2 * i) * DM, gw, ngw, lane); }
        SEAM(pb + 5, pb + 6);
        if (IN(pb + 6)) for (int rep_ = 0; rep_ < REP_UP; ++rep_) { KARGS(ap); unsigned char* ws = ap->P.ws;
            pg8::Gemm g{(const bf16*)ap->P.out, (const bf16*)(ws + WS_WUP) + (size_t)i * NUP * DM, MTOK, NUP, DM, DM, DM, 0};
            pg8::StaticOrder S; S.init(MTOK, NUP, G, bx);
            pg8::EpiFfnUp E{(bf16*)(ws + WS_ACT), (float*)(ws + WS_HALO), ap->P.conv_w + (size_t)i * 3 * NUP, ap->P.conv_b + (size_t)i * NUP};
            pg8::gemm_phase<pg8::EpiFfnUp, pg8::StaticOrder, true, true>(lds, g, S, E, wv); }
        SEAM(pb + 6, pb + 7);
        if (IN(pb + 7)) for (int rep_ = 0; rep_ < REP_FIX; ++rep_) { KARGS(ap); unsigned char* ws = ap->P.ws; const int tid_ = fresh_tid(wv);
            ffn_fixup((const float*)(ws + WS_HALO), (bf16*)(ws + WS_ACT), ap->P.conv_w + (size_t)i * 3 * NUP, ap->P.conv_b + (size_t)i * NUP, bx * 512 + tid_, G * 512); }
        SEAM(pb + 7, pb + 8);
        if (IN(pb + 8)) for (int rep_ = REP_DOWN - 1; rep_ >= 0; --rep_) { KARGS(ap); unsigned char* ws = ap->P.ws;
            pg8::Gemm g{(const bf16*)(ws + WS_ACT), (const bf16*)(ws + WS_WDN) + (size_t)i * DM * DFF, MTOK, DM, DFF, DFF, DFF, 0};
            pg8::StaticOrder S; S.init(MTOK, DM, G, bx);
            pg8::EpiRes E{nullptr, (short*)(ws + WS_YQ), (const float*)(ws + WS_STATS), ap->P.ln_g + (size_t)(2 * i) * DM, ap->P.ln_b + (size_t)(2 * i) * DM, ALPHA, 1};
            pg8::gemm_phase<pg8::EpiRes, pg8::StaticOrder, true, true>(lds, g, S, E, wv); }
        SEAM(pb + 8, pb + 9);
        if (IN(pb + 9)) for (int rep_ = REP_LN - 1; rep_ >= 0; --rep_) { KARGS(ap); unsigned char* ws = ap->P.ws; THIN_IDS();
            if (i == DEPTH - 1) ln_rows<true>((const short*)(ws + WS_YQ), ap->P.out, nullptr, nullptr, ap->P.ln_g + (size_t)(2 * i + 1) * DM, ap->P.ln_b + (size_t)(2 * i + 1) * DM, gw, ngw, lane);
            else ln_rows<false>((const short*)(ws + WS_YQ), nullptr, (bf16*)ap->P.out, (float*)(ws + WS_STATS), ap->P.ln_g + (size_t)(2 * i + 1) * DM, ap->P.ln_b + (size_t)(2 * i + 1) * DM, gw, ngw, lane); }
        SEAM(pb + 9, pb + 10);
    }
#undef IN
#undef SEAM
#undef THIN_IDS
}

extern "C" void kernel_launch(void* const* d_in, const int* in_sizes, int n_in, void* d_out, int out_size, void* d_ws, size_t ws_size, hipStream_t stream) {
    static int grid = 0;
    if (grid == 0) {
        if (n_in != 14 || out_size != MTOK * DM || ws_size < WS_END) { fprintf(stderr, "kernel_launch: unexpected shapes (n_in %d out %d ws %zu need %zu)\n", n_in, out_size, ws_size, (size_t)WS_END); grid = -1; return; }
        int dev = 0, cus = 0, per_cu = 0;
        if (hipGetDevice(&dev) != hipSuccess || hipDeviceGetAttribute(&cus, hipDeviceAttributeMultiprocessorCount, dev) != hipSuccess) { grid = -1; return; }
        if (hipFuncSetAttribute((const void*)mega, hipFuncAttributeMaxDynamicSharedMemorySize, LDS_BYTES) != hipSuccess) { fprintf(stderr, "kernel_launch: hipFuncSetAttribute failed\n"); grid = -1; return; }
        if (hipOccupancyMaxActiveBlocksPerMultiprocessor(&per_cu, (const void*)mega, 512, LDS_BYTES) != hipSuccess || per_cu < 1) fprintf(stderr, "kernel_launch: occupancy query says %d blocks per CU\n", per_cu);
        (void)hipGetLastError();
        grid = cus;
    }
    if (grid < 0) return;
    (void)hipMemsetAsync((char*)d_ws + WS_CTL, 0, CTL_ZERO_BYTES, stream);
    Args a; memset(&a, 0, sizeof a);
    Params& P = a.P;
    P.x = (const float*)d_in[0]; P.gla_w_in = (const float*)d_in[1]; P.gla_wgu = (const float*)d_in[2]; P.gla_gbias = (const float*)d_in[3]; P.gla_norm_g = (const float*)d_in[4]; P.gla_w_out = (const float*)d_in[5];
    P.dil_w_in = (const float*)d_in[6]; P.dil_w_out = (const float*)d_in[7]; P.ffn_w_up = (const float*)d_in[8]; P.conv_w = (const float*)d_in[9]; P.conv_b = (const float*)d_in[10]; P.ffn_w_down = (const float*)d_in[11];
    P.ln_g = (const float*)d_in[12]; P.ln_b = (const float*)d_in[13]; P.out = (float*)d_out; P.ws = (unsigned char*)d_ws;
#if MK_CUTS
    for (int k = 0; k < N_PHASES; ++k) { a.ph_lo = k; a.ph_hi = k + 1; hipLaunchKernelGGL(mega, dim3(grid), dim3(512), LDS_BYTES, stream, a); }
#else
    a.ph_lo = 0; a.ph_hi = N_PHASES;
    hipLaunchKernelGGL(mega, dim3(grid), dim3(512), LDS_BYTES, stream, a);
#endif
}
```

```cpp
#include <hip/hip_runtime.h>
#include <cstdio>
#include <cstdint>
#include <cstring>

__device__ __forceinline__ int fresh_tid(int wv) { int t; asm volatile("v_mbcnt_lo_u32_b32 %0, -1, 0\n\tv_mbcnt_hi_u32_b32 %0, -1, %0" : "=v"(t)); t += wv * 64; asm volatile("" : "+v"(t)); return t; }

__device__ __forceinline__ unsigned h2_pack(float lo, float hi) { const _Float16 a = (_Float16)lo, b = (_Float16)hi; return (unsigned)__builtin_bit_cast(unsigned short, a) | ((unsigned)__builtin_bit_cast(unsigned short, b) << 16); }
__device__ __forceinline__ float h_lo(unsigned w) { return (float)__builtin_bit_cast(_Float16, (unsigned short)(w & 0xffffu)); }
__device__ __forceinline__ float h_hi(unsigned w) { return (float)__builtin_bit_cast(_Float16, (unsigned short)(w >> 16)); }

namespace pg8 {
#define PG8_LAS __attribute__((address_space(3)))
typedef unsigned short bf16_t;
typedef short bf16x8 __attribute__((ext_vector_type(8)));
typedef float f32x4 __attribute__((ext_vector_type(4)));
typedef unsigned u32x4 __attribute__((ext_vector_type(4)));
typedef unsigned u32x2 __attribute__((ext_vector_type(2)));
constexpr int BM = 256, BK = 64, HALF = 128, HTB = HALF * BK * 2, STAGE_BYTES = 8 * HTB, NXCD = 8, WGM = 8;

__host__ __device__ __forceinline__ int lds_byte(int r, int c) { const int st = (r >> 4) * 2 + (c >> 5), rr = r & 15, cc = c & 31, ob = rr * 64 + cc * 2; return st * 1024 + (ob ^ (((ob >> 9) & 1) << 5)); }
__host__ __device__ __forceinline__ void stage_rc(int b, int& R, int& C) { const int st = b / 1024, sb = b % 1024, swz = sb ^ (((sb >> 9) & 1) << 5); R = (st >> 1) * 16 + swz / 64; C = (st & 1) * 32 + (swz % 64) / 2; }
__host__ __device__ __forceinline__ int perm32(int rho) { const int n = rho >> 4, i = rho & 15; return 8 * (i >> 2) + 4 * n + (i & 3); }

struct Unit { int pm, pn; };
struct Gemm { const bf16_t* A; const bf16_t* Bt; int M, N, K, lda, ldb, pad; };

struct StaticOrder {
    int nM, nN, nwg, G, c;
    __host__ __device__ void init(int M, int N, int G_, int c_) { nM = M / BM; nN = N / BM; nwg = nM * nN; G = G_; c = c_; }
    __host__ __device__ bool next(int i, Unit& u) const {
        const long L = (long)i * G + c; if (L >= nwg) return false;
        int wgid = (int)L; { const int q = nwg / NXCD, r = nwg % NXCD, xcd = wgid % NXCD, off = wgid / NXCD; wgid = (xcd < r ? xcd * (q + 1) : r * (q + 1) + (xcd - r) * q) + off; }
        const int nig = WGM * nN, gid = wgid / nig, fm = gid * WGM, gsz = (nM - fm) < WGM ? (nM - fm) : WGM;
        u.pm = fm + ((wgid % nig) % gsz); u.pn = (wgid % nig) / gsz; return true;
    }
    __device__ __forceinline__ void a_ready(const Unit&) const {}
    __device__ __forceinline__ void done(const Unit&) const {}
};

__device__ __forceinline__ unsigned cvt_pk_bf16(float lo, float hi) { unsigned r; asm volatile("v_cvt_pk_bf16_f32 %0, %1, %2" : "=v"(r) : "v"(lo), "v"(hi)); return r; }

struct EpiBf16Plain {
    static constexpr bool PERM = true, AFTER_DRAIN = false, NEEDS_LDS = false;
    bf16_t* O; int ldc; int pad;
    __device__ __forceinline__ void operator()(f32x4 (&acc)[2][2][4][2], const Unit& u, int wr, int wc, int fr, int fq) const {
        const int row0 = u.pm * BM + wr * 64 + fr, col0 = u.pn * BM + wc * 32 + 8 * fq;
#pragma unroll
        for (int ai = 0; ai < 2; ++ai)
#pragma unroll
            for (int m = 0; m < 4; ++m) { bf16_t* rowp = O + (size_t)(row0 + ai * HALF + m * 16) * ldc + col0;
#pragma unroll
                for (int bj = 0; bj < 2; ++bj) { const f32x4 v0 = acc[ai][bj][m][0], v1 = acc[ai][bj][m][1];
                    u32x4 w; w.x = cvt_pk_bf16(v0[0], v0[1]); w.y = cvt_pk_bf16(v0[2], v0[3]); w.z = cvt_pk_bf16(v1[0], v1[1]); w.w = cvt_pk_bf16(v1[2], v1[3]);
                    __builtin_nontemporal_store(w, (u32x4*)(rowp + bj * HALF)); } }
    }
};
struct EpiGlaIn {
    static constexpr bool PERM = true, AFTER_DRAIN = false, NEEDS_LDS = false;
    bf16_t* QK; float* GLOW; size_t seg;
    __device__ __forceinline__ void operator()(f32x4 (&acc)[2][2][4][2], const Unit& u, int wr, int wc, int fr, int fq) const {
        const int row0 = u.pm * BM + wr * 64 + fr;
        if (u.pn < 24) {
            bf16_t* base = QK + (size_t)(u.pn >> 3) * seg;
            const int col0 = (u.pn & 7) * BM + wc * 32 + 8 * fq;
#pragma unroll
            for (int ai = 0; ai < 2; ++ai)
#pragma unroll
                for (int m = 0; m < 4; ++m) { bf16_t* rowp = base + (size_t)(row0 + ai * HALF + m * 16) * 2048 + col0;
#pragma unroll
                    for (int bj = 0; bj < 2; ++bj) { const f32x4 v0 = acc[ai][bj][m][0], v1 = acc[ai][bj][m][1];
                        u32x4 w; w.x = cvt_pk_bf16(v0[0], v0[1]); w.y = cvt_pk_bf16(v0[2], v0[3]); w.z = cvt_pk_bf16(v1[0], v1[1]); w.w = cvt_pk_bf16(v1[2], v1[3]);
                        __builtin_nontemporal_store(w, (u32x4*)(rowp + bj * HALF)); } }
        } else if (wc == 0 && fq < 2) {
#pragma unroll
            for (int ai = 0; ai < 2; ++ai)
#pragma unroll
                for (int m = 0; m < 4; ++m) { float* rowp = GLOW + (size_t)(row0 + ai * HALF + m * 16) * 16 + 8 * fq;
                    *(f32x4*)(rowp) = acc[ai][0][m][0]; *(f32x4*)(rowp + 4) = acc[ai][0][m][1]; }
        }
    }
};
struct EpiRes {
    static constexpr bool PERM = true, AFTER_DRAIN = false, NEEDS_LDS = false;
    const float* xin; short* yq; const float* stats; const float* gam; const float* bet; float alpha; int norm;
    __device__ __forceinline__ void operator()(f32x4 (&acc)[2][2][4][2], const Unit& u, int wr, int wc, int fr, int fq) const {
        asm volatile("" ::: "memory");
        const int row0 = u.pm * BM + wr * 64 + fr, col0 = u.pn * BM + wc * 32 + 8 * fq;
        f32x4 gv[2][2], bv[2][2];
        if (norm) {
#pragma unroll
            for (int bj = 0; bj < 2; ++bj)
#pragma unroll
                for (int n = 0; n < 2; ++n) { gv[bj][n] = *(const f32x4*)(gam + col0 + bj * HALF + n * 4); bv[bj][n] = *(const f32x4*)(bet + col0 + bj * HALF + n * 4); }
        }
        if (norm) {
            u32x4 qa[4][2], qb[4][2]; float sca[4], sha[4], scb[4], shb[4];
#define ER_LOAD(q, s, t, ai, h) do { const int row_ = row0 + (ai) * HALF + (h) * 16; const size_t off_ = (size_t)row_ * 2048 + col0; const float mean_ = stats[2 * row_], rstd_ = stats[2 * row_ + 1]; s[h] = rstd_; t[h] = -mean_ * rstd_; \
                q[h][0] = *(const u32x4*)(yq + off_); q[h][1] = *(const u32x4*)(yq + off_ + HALF); } while (0)
#define ER_DO(q, s, t, ai, h) do { const size_t off_ = (size_t)(row0 + (ai) * HALF + (h) * 16) * 2048 + col0; \
                _Pragma("unroll") for (int bj = 0; bj < 2; ++bj) { u32x4 o; \
                    _Pragma("unroll") for (int n = 0; n < 2; ++n) { const unsigned w0 = q[h][bj][2 * n], w1 = q[h][bj][2 * n + 1]; \
                        f32x4 qq; qq[0] = h_lo(w0); qq[1] = h_hi(w0); qq[2] = h_lo(w1); qq[3] = h_hi(w1); \
                        const f32x4 x = (qq * s[h] + t[h]) * gv[bj][n] + bv[bj][n]; const f32x4 y = x * alpha + acc[ai][bj][h][n]; \
                        o[2 * n] = h2_pack(y[0], y[1]); o[2 * n + 1] = h2_pack(y[2], y[3]); } \
                    __builtin_nontemporal_store(o, (u32x4*)(yq + off_ + bj * HALF)); } } while (0)
            ER_LOAD(qa, sca, sha, 0, 0); ER_LOAD(qa, sca, sha, 0, 1); ER_LOAD(qa, sca, sha, 0, 2); ER_LOAD(qa, sca, sha, 0, 3);
            asm volatile("" ::: "memory");
            ER_DO(qa, sca, sha, 0, 0); ER_DO(qa, sca, sha, 0, 1);
            asm volatile("" ::: "memory");
            ER_LOAD(qb, scb, shb, 1, 0); ER_LOAD(qb, scb, shb, 1, 1);
            asm volatile("" ::: "memory");
            ER_DO(qa, sca, sha, 0, 2); ER_DO(qa, sca, sha, 0, 3);
            asm volatile("" ::: "memory");
            ER_LOAD(qb, scb, shb, 1, 2); ER_LOAD(qb, scb, shb, 1, 3);
            asm volatile("" ::: "memory");
            ER_DO(qb, scb, shb, 1, 0); ER_DO(qb, scb, shb, 1, 1); ER_DO(qb, scb, shb, 1, 2); ER_DO(qb, scb, shb, 1, 3);
            asm volatile("" ::: "memory");
#undef ER_LOAD
#undef ER_DO
        } else {
#pragma unroll
            for (int ai = 0; ai < 2; ++ai)
#pragma unroll
                for (int m = 0; m < 4; ++m) { const size_t off = (size_t)(row0 + ai * HALF + m * 16) * 2048 + col0;
                    f32x4 xv[2][2];
#pragma unroll
                    for (int bj = 0; bj < 2; ++bj)
#pragma unroll
                        for (int n = 0; n < 2; ++n) xv[bj][n] = *(const f32x4*)(xin + off + bj * HALF + n * 4);
#pragma unroll
                    for (int bj = 0; bj < 2; ++bj) { u32x4 o;
#pragma unroll
                        for (int n = 0; n < 2; ++n) { const f32x4 y = xv[bj][n] * alpha + acc[ai][bj][m][n]; o[2 * n] = h2_pack(y[0], y[1]); o[2 * n + 1] = h2_pack(y[2], y[3]); }
                        __builtin_nontemporal_store(o, (u32x4*)(yq + off + bj * HALF)); }
                    asm volatile("" ::: "memory"); }
        }
    }
};

template <int N> __device__ __forceinline__ float row_ror(float v) { return __builtin_bit_cast(float, __builtin_amdgcn_update_dpp(0, __builtin_bit_cast(int, v), 0x120 + N, 0xf, 0xf, false)); }
template <int CTRL> __device__ __forceinline__ float dpp0(float v) { return __builtin_bit_cast(float, __builtin_amdgcn_update_dpp(0, __builtin_bit_cast(int, v), CTRL, 0xf, 0xf, true)); }
struct EpiFfnUp {
    static constexpr bool PERM = true, AFTER_DRAIN = false, NEEDS_LDS = true;
    bf16_t* ACT; float* HALO; const float* cw; const float* cb;
    __device__ __forceinline__ void run(f32x4 (&acc)[2][2][4][2], const Unit& u, int wr, int wc, int fr, int fq, PG8_LAS unsigned char* xl) const {
        PG8_LAS float* X = (PG8_LAS float*)xl;
        const int lane = fq * 16 + fr, cc0 = 32 * wc + 8 * fq;
        f32x4 cwv[2][2][4];
#pragma unroll
        for (int n = 0; n < 2; ++n)
#pragma unroll
            for (int bj = 0; bj < 2; ++bj) { const int col = bj * 5504 + u.pn * 128 + cc0 + 4 * n;
                cwv[n][bj][0] = *(const f32x4*)(cw + col); cwv[n][bj][1] = *(const f32x4*)(cw + 11008 + col); cwv[n][bj][2] = *(const f32x4*)(cw + 22016 + col); cwv[n][bj][3] = *(const f32x4*)(cb + col); }
        __builtin_amdgcn_sched_barrier(0);
        if (fr >= 14) {
#pragma unroll
            for (int ai = 0; ai < 2; ++ai) { const int sg = 2 * ai + wr;
#pragma unroll
                for (int bj = 0; bj < 2; ++bj)
#pragma unroll
                    for (int n = 0; n < 2; ++n) *(PG8_LAS f32x4*)(X + ((sg * 2 + (fr - 14)) * 256 + bj * 128 + cc0 + 4 * n)) = acc[ai][bj][3][n]; }
            if (wr == 1) {
                float* hp = HALO + ((size_t)u.pm * 4 + 2 + (fr - 14)) * 11008 + u.pn * 256 + cc0;
#pragma unroll
                for (int bj = 0; bj < 2; ++bj)
#pragma unroll
                    for (int n = 0; n < 2; ++n) *(f32x4*)(hp + bj * 128 + 4 * n) = acc[1][bj][3][n];
            }
        }
        if (fr < 2 && wr == 0) {
            float* hp = HALO + ((size_t)u.pm * 4 + fr) * 11008 + u.pn * 256 + cc0;
#pragma unroll
            for (int bj = 0; bj < 2; ++bj)
#pragma unroll
                for (int n = 0; n < 2; ++n) *(f32x4*)(hp + bj * 128 + 4 * n) = acc[0][bj][0][n];
        }
        asm volatile("s_waitcnt lgkmcnt(0)" ::: "memory"); __builtin_amdgcn_s_barrier(); asm volatile("" ::: "memory");
        f32x4 Qv[2][2][2];
#pragma unroll
        for (int n = 0; n < 2; ++n)
#pragma unroll
            for (int bj = 0; bj < 2; ++bj)
#pragma unroll
                for (int ai = 0; ai < 2; ++ai) { const int sg = 2 * ai + wr; Qv[n][bj][ai] = (f32x4){0.f, 0.f, 0.f, 0.f};
                    if (sg > 0) Qv[n][bj][ai] = *(const PG8_LAS f32x4*)(X + (((sg - 1) * 2 + (fr & 1)) * 256 + bj * 128 + cc0 + 4 * n)); }
        __builtin_amdgcn_sched_barrier(0);
#pragma unroll
        for (int n = 0; n < 2; ++n) {
#pragma unroll
            for (int bj = 0; bj < 2; ++bj) {
                const f32x4 w0 = cwv[n][bj][0], w1 = cwv[n][bj][1], w2 = cwv[n][bj][2], bb = cwv[n][bj][3];
#pragma unroll
                for (int ai = 0; ai < 2; ++ai) { const int sg = 2 * ai + wr;
                    const f32x4 Q = Qv[n][bj][ai];
                    asm volatile("" : "+v"(acc[ai][bj][0][n]), "+v"(acc[ai][bj][1][n]), "+v"(acc[ai][bj][2][n]), "+v"(acc[ai][bj][3][n]));
#pragma unroll
                    for (int m = 3; m >= 0; --m) {
                        const f32x4 cur = acc[ai][bj][m][n], prv = m > 0 ? acc[ai][bj][m - 1][n] : Q;
                        f32x4 o = w2 * cur + bb;
                        float o0 = o[0], o1 = o[1], o2 = o[2], o3 = o[3];
                        asm volatile("s_nop 1\n\t"
                            "v_fmac_f32_dpp %0, %4, %12 row_shr:1 row_mask:0xf bank_mask:0xf\n\tv_fmac_f32_dpp %1, %5, %13 row_shr:1 row_mask:0xf bank_mask:0xf\n\t"
                            "v_fmac_f32_dpp %2, %6, %14 row_shr:1 row_mask:0xf bank_mask:0xf\n\tv_fmac_f32_dpp %3, %7, %15 row_shr:1 row_mask:0xf bank_mask:0xf\n\t"
                            "v_fmac_f32_dpp %0, %8, %12 row_shl:15 row_mask:0xf bank_mask:0xf\n\tv_fmac_f32_dpp %1, %9, %13 row_shl:15 row_mask:0xf bank_mask:0xf\n\t"
                            "v_fmac_f32_dpp %2, %10, %14 row_shl:15 row_mask:0xf bank_mask:0xf\n\tv_fmac_f32_dpp %3, %11, %15 row_shl:15 row_mask:0xf bank_mask:0xf\n\t"
                            "v_fmac_f32_dpp %0, %4, %16 row_shr:2 row_mask:0xf bank_mask:0xf\n\tv_fmac_f32_dpp %1, %5, %17 row_shr:2 row_mask:0xf bank_mask:0xf\n\t"
                            "v_fmac_f32_dpp %2, %6, %18 row_shr:2 row_mask:0xf bank_mask:0xf\n\tv_fmac_f32_dpp %3, %7, %19 row_shr:2 row_mask:0xf bank_mask:0xf\n\t"
                            "v_fmac_f32_dpp %0, %8, %16 row_shl:14 row_mask:0xf bank_mask:0xf\n\tv_fmac_f32_dpp %1, %9, %17 row_shl:14 row_mask:0xf bank_mask:0xf\n\t"
                            "v_fmac_f32_dpp %2, %10, %18 row_shl:14 row_mask:0xf bank_mask:0xf\n\tv_fmac_f32_dpp %3, %11, %19 row_shl:14 row_mask:0xf bank_mask:0xf"
                            : "+v"(o0), "+v"(o1), "+v"(o2), "+v"(o3)
                            : "v"(cur[0]), "v"(cur[1]), "v"(cur[2]), "v"(cur[3]), "v"(prv[0]), "v"(prv[1]), "v"(prv[2]), "v"(prv[3]),
                              "v"(w1[0]), "v"(w1[1]), "v"(w1[2]), "v"(w1[3]), "v"(w0[0]), "v"(w0[1]), "v"(w0[2]), "v"(w0[3]));
                        o[0] = o0; o[1] = o1; o[2] = o2; o[3] = o3;
                        acc[ai][bj][m][n] = o;
                    }
                    asm volatile("" : "+v"(acc[ai][bj][0][n]), "+v"(acc[ai][bj][1][n]), "+v"(acc[ai][bj][2][n]), "+v"(acc[ai][bj][3][n]));
                    __builtin_amdgcn_sched_barrier(0);
                }
            }
        }
        const int row0 = u.pm * BM + wr * 64 + fr;
#pragma unroll
        for (int ai = 0; ai < 2; ++ai)
#pragma unroll
            for (int m = 0; m < 4; ++m) {
                f32x4 a[2];
#pragma unroll
                for (int n = 0; n < 2; ++n) { const f32x4 g = acc[ai][0][m][n], up = acc[ai][1][m][n]; const f32x4 t = g * -1.4426950408889634f; f32x4 e;
#pragma unroll
                    for (int i = 0; i < 4; ++i) e[i] = __builtin_amdgcn_exp2f(t[i]);
                    const f32x4 d = e + 1.f; f32x4 r;
#pragma unroll
                    for (int i = 0; i < 4; ++i) r[i] = __builtin_amdgcn_rcpf(d[i]);
                    a[n] = (g * up) * r; }
                u32x4 w; w.x = cvt_pk_bf16(a[0][0], a[0][1]); w.y = cvt_pk_bf16(a[0][2], a[0][3]); w.z = cvt_pk_bf16(a[1][0], a[1][1]); w.w = cvt_pk_bf16(a[1][2], a[1][3]);
                if (!(ai == 0 && m == 0 && wr == 0 && fr < 2)) __builtin_nontemporal_store(w, (u32x4*)(ACT + (size_t)(row0 + ai * HALF + m * 16) * 5504 + u.pn * 128 + cc0));
            }
    }
};

template <class Epi, class Sched, bool ALIGN_EPI = false, bool SP2 = false>
__device__ __forceinline__ void gemm_phase(PG8_LAS unsigned char* lds, const Gemm g, const Sched& S, const Epi& E, int wv) {
    const int tid = fresh_tid(wv), wid = __builtin_amdgcn_readfirstlane(tid >> 6), lane = tid & 63, wr = wid >> 2, wc = wid & 3, fr = lane & 15, fq = lane >> 4;
    const int K = g.K, nt = K / BK;
    unsigned voffA[2], voffB[2];
#pragma unroll
    for (int i = 0; i < 2; ++i) { int R, C; stage_rc(tid * 16 + i * 8192, R, C); const int Rb = Epi::PERM ? ((R & ~31) + perm32(R & 31)) : R;
        voffA[i] = (unsigned)(R * g.lda + C) * 2u; voffB[i] = (unsigned)(Rb * g.ldb + C) * 2u; }
    const size_t kstep = (size_t)(BK * 2);
    const size_t hstepA = (size_t)HALF * g.lda * 2, hstepB = (size_t)HALF * g.ldb * 2;
    const size_t tstepA = 2 * hstepA, tstepB = 2 * hstepB;
    const unsigned ldsw = (unsigned)wid * 1024u;
    const int aoff = lds_byte(wr * 64 + fr, fq * 8), boff = lds_byte(wc * 32 + fr, fq * 8);
#define PG8_SA(b, h) (((b) * 2 + (h)) * HTB)
#define PG8_SB(b, h) ((4 + (b) * 2 + (h)) * HTB)
#define PG8_STAGE(bufoff, gbase, voff) do { _Pragma("unroll") for (int _i = 0; _i < 2; ++_i) \
        __builtin_amdgcn_global_load_lds((const unsigned*)((const char*)(gbase) + (voff)[_i]), (PG8_LAS unsigned*)(lds + (bufoff) + ldsw + _i * 8192), 16, 0, 0); } while (0)
#define PG8_LDA(dst, b, h) do { _Pragma("unroll") for (int m = 0; m < 4; ++m) _Pragma("unroll") for (int k = 0; k < 2; ++k) dst[m][k] = *(const PG8_LAS bf16x8*)(lds + PG8_SA(b, h) + aoff + m * 2048 + k * 1024); } while (0)
#define PG8_LDB(dst, b, h) do { _Pragma("unroll") for (int n = 0; n < 2; ++n) _Pragma("unroll") for (int k = 0; k < 2; ++k) dst[n][k] = *(const PG8_LAS bf16x8*)(lds + PG8_SB(b, h) + boff + n * 2048 + k * 1024); } while (0)
#define PG8_MMA(ai, bj, At, Bt) do { __builtin_amdgcn_s_setprio(1); _Pragma("unroll") for (int m = 0; m < 4; ++m) _Pragma("unroll") for (int n = 0; n < 2; ++n) _Pragma("unroll") for (int k = 0; k < 2; ++k) \
        acc[ai][bj][m][n] = __builtin_amdgcn_mfma_f32_16x16x32_bf16(Bt[n][k], At[m][k], acc[ai][bj][m][n], 0, 0, 0); __builtin_amdgcn_s_setprio(0); } while (0)
#define PG8_WAIT_V(n) asm volatile("s_waitcnt vmcnt(" #n ")" ::: "memory")
#define PG8_WAIT_L(n) asm volatile("s_waitcnt lgkmcnt(" #n ")" ::: "memory")
#define PG8_BAR __builtin_amdgcn_s_barrier()
#define PG8_SCHED __builtin_amdgcn_sched_barrier(0)
    Unit cur, nxt; int ui = 0;
    if (!S.next(0, cur)) return;
    f32x4 acc[2][2][4][2];
#pragma unroll
    for (int a = 0; a < 2; ++a)
#pragma unroll
        for (int b = 0; b < 2; ++b)
#pragma unroll
            for (int m = 0; m < 4; ++m)
#pragma unroll
                for (int n = 0; n < 2; ++n) acc[a][b][m][n] = (f32x4){0.f, 0.f, 0.f, 0.f};
    bf16x8 At[4][2], B0[2][2], B1[2][2];
    const char* cA = (const char*)g.A + (size_t)cur.pm * tstepA; const char* cB = (const char*)g.Bt + (size_t)cur.pn * tstepB;
    S.a_ready(cur);
    if constexpr (SP2) {
        PG8_STAGE(PG8_SB(0, 0), cB, voffB); PG8_STAGE(PG8_SB(0, 1), cB + hstepB, voffB); PG8_STAGE(PG8_SA(0, 0), cA, voffA); PG8_STAGE(PG8_SA(0, 1), cA + hstepA, voffA);
        if (wr == 1) PG8_BAR;
        PG8_WAIT_V(2); PG8_BAR;
        PG8_STAGE(PG8_SB(1, 0), cB + kstep, voffB); PG8_STAGE(PG8_SA(1, 0), cA + kstep, voffA); PG8_STAGE(PG8_SB(1, 1), cB + hstepB + kstep, voffB);
        PG8_WAIT_V(6); PG8_BAR;
    } else {
        PG8_STAGE(PG8_SB(0, 0), cB, voffB); PG8_STAGE(PG8_SA(0, 0), cA, voffA); PG8_STAGE(PG8_SB(0, 1), cB + hstepB, voffB); PG8_STAGE(PG8_SA(0, 1), cA + hstepA, voffA);
        if (wr == 1) PG8_BAR;
        PG8_WAIT_V(4); PG8_BAR;
        PG8_STAGE(PG8_SB(1, 0), cB + kstep, voffB); PG8_STAGE(PG8_SA(1, 0), cA + kstep, voffA); PG8_STAGE(PG8_SB(1, 1), cB + hstepB + kstep, voffB);
        PG8_WAIT_V(6); PG8_BAR;
    }
    for (;;) {
        const bool has_next = S.next(ui + 1, nxt);
        const char* nA = has_next ? (const char*)g.A + (size_t)nxt.pm * tstepA : cA; const char* nB = has_next ? (const char*)g.Bt + (size_t)nxt.pn * tstepB : cB;
        for (int t = 0; t < nt; t += 2) {
            const bool last = (t == nt - 2);
            const char* a1 = cA + (size_t)(t + 1) * kstep;
            const char* a2 = last ? nA : cA + (size_t)(t + 2) * kstep; const char* b2 = last ? nB : cB + (size_t)(t + 2) * kstep;
            const char* a3 = a2 + kstep; const char* b3 = b2 + kstep;
            asm volatile("" : "+s"(a3), "+s"(b3));
            if (last && has_next) S.a_ready(nxt);
            asm volatile("" : "+v"(voffA[0]), "+v"(voffA[1]), "+v"(voffB[0]), "+v"(voffB[1]));
            if constexpr (SP2) {
            PG8_LDB(B0, 0, 0); PG8_LDB(B1, 0, 1); PG8_SCHED; PG8_LDA(At, 0, 0); PG8_STAGE(PG8_SA(1, 1), a1 + hstepA, voffA);
            PG8_WAIT_V(8); PG8_WAIT_L(0); PG8_BAR; PG8_MMA(0, 0, At, B0); PG8_MMA(0, 1, At, B1); PG8_BAR; PG8_SCHED;
            PG8_LDA(At, 0, 1); PG8_STAGE(PG8_SB(0, 0), b2, voffB); PG8_STAGE(PG8_SB(0, 1), b2 + hstepB, voffB); PG8_STAGE(PG8_SA(0, 0), a2, voffA);
            PG8_WAIT_V(8); PG8_WAIT_L(0); PG8_BAR; PG8_MMA(1, 0, At, B0); PG8_MMA(1, 1, At, B1); PG8_BAR; PG8_SCHED;
            PG8_LDB(B0, 1, 0); PG8_LDB(B1, 1, 1); PG8_SCHED; PG8_LDA(At, 1, 0); PG8_STAGE(PG8_SA(0, 1), a2 + hstepA, voffA);
            PG8_WAIT_V(8); PG8_WAIT_L(0); PG8_BAR; PG8_MMA(0, 0, At, B0); PG8_MMA(0, 1, At, B1); PG8_BAR; PG8_SCHED;
            PG8_LDA(At, 1, 1); PG8_STAGE(PG8_SB(1, 0), b3, voffB); PG8_STAGE(PG8_SB(1, 1), b3 + hstepB, voffB); PG8_STAGE(PG8_SA(1, 0), a3, voffA);
            PG8_WAIT_V(8); PG8_WAIT_L(0); PG8_BAR; PG8_MMA(1, 0, At, B0); PG8_MMA(1, 1, At, B1); PG8_BAR; PG8_SCHED;
            } else {
            PG8_LDB(B0, 0, 0); PG8_SCHED; PG8_LDA(At, 0, 0); PG8_STAGE(PG8_SA(1, 1), a1 + hstepA, voffA);
            PG8_WAIT_L(8); PG8_BAR; PG8_WAIT_L(0); PG8_MMA(0, 0, At, B0); PG8_BAR; PG8_SCHED;
            PG8_LDB(B1, 0, 1); PG8_STAGE(PG8_SB(0, 0), b2, voffB);
            PG8_BAR; PG8_WAIT_L(0); PG8_MMA(0, 1, At, B1); PG8_BAR;
            PG8_LDA(At, 0, 1); PG8_STAGE(PG8_SA(0, 0), a2, voffA);
            PG8_BAR; PG8_WAIT_L(0); PG8_MMA(1, 0, At, B0); PG8_BAR; PG8_SCHED;
            PG8_STAGE(PG8_SB(0, 1), b2 + hstepB, voffB);
            PG8_WAIT_V(6); PG8_BAR; PG8_MMA(1, 1, At, B1); PG8_BAR;
            PG8_LDB(B0, 1, 0); PG8_SCHED; PG8_LDA(At, 1, 0); PG8_STAGE(PG8_SA(0, 1), a2 + hstepA, voffA);
            PG8_WAIT_L(8); PG8_BAR; PG8_WAIT_L(0); PG8_MMA(0, 0, At, B0); PG8_BAR; PG8_SCHED;
            PG8_LDB(B1, 1, 1); PG8_STAGE(PG8_SB(1, 0), b3, voffB);
            PG8_BAR; PG8_WAIT_L(0); PG8_MMA(0, 1, At, B1); PG8_BAR;
            PG8_LDA(At, 1, 1); PG8_STAGE(PG8_SA(1, 0), a3, voffA);
            PG8_BAR; PG8_WAIT_L(0); PG8_MMA(1, 0, At, B0); PG8_BAR; PG8_SCHED;
            PG8_STAGE(PG8_SB(1, 1), b3 + hstepB, voffB);
            PG8_WAIT_V(6); PG8_BAR; PG8_MMA(1, 1, At, B1); PG8_BAR;
            }
        }
        if constexpr (ALIGN_EPI) { if (wr == 0) PG8_BAR; }
        { const int le_ = fresh_tid(wv) & 63, fre_ = le_ & 15, fqe_ = le_ >> 4;
          if constexpr (Epi::NEEDS_LDS) { static_assert(ALIGN_EPI, "an epilogue with a workgroup barrier needs both halves in it together"); E.run(acc, cur, wr, wc, fre_, fqe_, lds + STAGE_BYTES); S.done(cur); }
          else { E(acc, cur, wr, wc, fre_, fqe_); S.done(cur); } }
        if (!has_next) break;
#pragma unroll
        for (int a = 0; a < 2; ++a)
#pragma unroll
            for (int b = 0; b < 2; ++b)
#pragma unroll
                for (int m = 0; m < 4; ++m)
#pragma unroll
                    for (int n = 0; n < 2; ++n) acc[a][b][m][n] = (f32x4){0.f, 0.f, 0.f, 0.f};
        cur = nxt; cA = nA; cB = nB; ++ui;
        if constexpr (ALIGN_EPI) { if (wr == 1) PG8_BAR; }
    }
    PG8_WAIT_V(0);
    if constexpr (!ALIGN_EPI) { if (wr == 0) PG8_BAR; }
    PG8_BAR;
#undef PG8_SA
#undef PG8_SB
#undef PG8_STAGE
#undef PG8_LDA
#undef PG8_LDB
#undef PG8_MMA
#undef PG8_WAIT_V
#undef PG8_WAIT_L
#undef PG8_BAR
#undef PG8_SCHED
}
}

#define LAS __attribute__((address_space(3)))
typedef unsigned short bf16;
typedef float f32x4 __attribute__((ext_vector_type(4)));
typedef unsigned u32x4 __attribute__((ext_vector_type(4)));
typedef unsigned u32x2 __attribute__((ext_vector_type(2)));

constexpr int DM = 2048, BATCH = 16, SEQ = 2048, MTOK = BATCH * SEQ, DEPTH = 4;
constexpr int GLA_H = 4, GLA_DK = 1024, GLA_DV = 2048, GLA_HK = 256, GLA_HV = 512, GLA_RANK = 16, GLA_IN = 6160, GLA_NPAD = 6400;
constexpr int DIL_HEADS = 8, DIL_HD = 128, DIL_WIDTH = 1024, DIL_IN = 9216;
constexpr int DFF = 5504, NUP = 2 * DFF;
constexpr float ALPHA = 1.6817928305074292f;
constexpr float LN_EPS = 1e-5f, RMS_EPS = 1e-6f;
constexpr float LOG2E = 1.4426950408889634f;

constexpr size_t MiB = 1u << 20;
constexpr size_t WS_CTL = 0;
constexpr size_t WS_WGI = 2 * MiB;
constexpr size_t WS_WGO = WS_WGI + 50 * MiB;
constexpr size_t WS_WDI = WS_WGO + 16 * MiB;
constexpr size_t WS_WDO = WS_WDI + 72 * MiB;
constexpr size_t WS_WUP = WS_WDO + 8 * MiB;
constexpr size_t WS_WDN = WS_WUP + 172 * MiB;
constexpr size_t WS_YQ  = WS_WDN + 86 * MiB;
constexpr size_t WS_HALO = WS_YQ + 128 * MiB;
constexpr size_t WS_STATS = WS_HALO + 22544384;
constexpr size_t WS_REG = WS_HALO + 22 * MiB;
static_assert(WS_STATS + (size_t)MTOK * 8 <= WS_REG, "stats fit behind the halo rows");
constexpr size_t WS_QK = WS_REG, WS_V = WS_QK + 128 * MiB, WS_R = WS_V + 128 * MiB, WS_GLOW = WS_R + 128 * MiB, WS_IMG = WS_GLOW + 2 * MiB, WS_VT = WS_IMG + 146 * MiB, WS_O = WS_QK;
constexpr size_t WS_PROJ = WS_REG, WS_OG = WS_PROJ + 576 * MiB, WS_LSE = WS_OG + 192 * MiB;
constexpr size_t WS_ACT = WS_REG;
constexpr size_t WS_END = WS_REG + 771 * MiB;

__device__ __forceinline__ unsigned f2bf(float f) { unsigned u = __builtin_bit_cast(unsigned, f); return (u + 0x7fffu + ((u >> 16) & 1u)) >> 16; }
__device__ __forceinline__ unsigned pk2(float lo, float hi) { return f2bf(lo) | (f2bf(hi) << 16); }
__device__ __forceinline__ float bf2f(unsigned short b) { return __builtin_bit_cast(float, (unsigned)b << 16); }
__device__ __forceinline__ float bflo(unsigned w) { return __builtin_bit_cast(float, w << 16); }
__device__ __forceinline__ float bfhi(unsigned w) { return __builtin_bit_cast(float, w & 0xffff0000u); }
__device__ __forceinline__ float wave_sum(float v) {
#define WS_DPP_ADD(ctrl, rmask) v += __builtin_bit_cast(float, __builtin_amdgcn_update_dpp(0, __builtin_bit_cast(int, v), ctrl, rmask, 0xf, true))
    WS_DPP_ADD(0x111, 0xf); WS_DPP_ADD(0x112, 0xf); WS_DPP_ADD(0x114, 0xf); WS_DPP_ADD(0x118, 0xf); WS_DPP_ADD(0x142, 0xa); WS_DPP_ADD(0x143, 0xc);
#undef WS_DPP_ADD
    return __builtin_bit_cast(float, __builtin_amdgcn_readlane(__builtin_bit_cast(int, v), 63));
}

struct Params {
    const float* x; const float* gla_w_in; const float* gla_wgu; const float* gla_gbias; const float* gla_norm_g; const float* gla_w_out;
    const float* dil_w_in; const float* dil_w_out; const float* ffn_w_up; const float* conv_w; const float* conv_b; const float* ffn_w_down;
    const float* ln_g; const float* ln_b; float* out; unsigned char* ws;
};

__device__ __forceinline__ void transpose_item(const float* W, int K, int N, bf16* WT, int dest_row0, LAS float* scr, int k0, int n0, int lane) {
#pragma unroll 8
    for (int i = 0; i < 32; ++i) { const int kk = 2 * i + (lane >> 5); scr[kk * 33 + (lane & 31)] = W[(size_t)(k0 + kk) * N + n0 + (lane & 31)]; }
    asm volatile("s_waitcnt lgkmcnt(0)" ::: "memory");
    const int c = lane & 7;
#pragma unroll
    for (int j = 0; j < 4; ++j) { const int n = (lane >> 3) + 8 * j; const LAS float* s = scr + (8 * c) * 33 + n;
        u32x4 o; o.x = pk2(s[0 * 33], s[1 * 33]); o.y = pk2(s[2 * 33], s[3 * 33]); o.z = pk2(s[4 * 33], s[5 * 33]); o.w = pk2(s[6 * 33], s[7 * 33]);
        *(u32x4*)(WT + (size_t)(dest_row0 + n) * K + k0 + 8 * c) = o; }
    asm volatile("s_waitcnt lgkmcnt(0)" ::: "memory");
}
template <int MAP> __device__ __forceinline__ void transpose_matrix(const float* W, int K, int N, int ncols, bf16* WT, LAS float* scr, int gw, int ngw, int lane) {
    const int nnb = ncols / 32, items = (K / 64) * nnb;
    for (int it = gw; it < items; it += ngw) {
        const int kb = it / nnb, nb = it % nnb, n0 = nb * 32;
        int dr = n0;
        if (MAP == 1) { dr = n0 < DFF ? 256 * (n0 / 128) + (n0 % 128) : 256 * ((n0 - DFF) / 128) + 128 + ((n0 - DFF) % 128); }
        transpose_item(W, K, N, WT, dr, scr, kb * 64, n0, lane);
    }
}
__device__ __forceinline__ void prologue(const Params& P, LAS unsigned char* lds, int bx, int G, int wv) {
    const int tid = fresh_tid(wv), lane = tid & 63, wave = tid >> 6;
    LAS float* scr = (LAS float*)(lds + wave * 8448);
    const int gw = bx * 8 + wave, ngw = G * 8;
    unsigned char* ws = P.ws;
    for (int j = 0; j < 2; ++j) {
        transpose_matrix<0>(P.gla_w_in + (size_t)j * DM * GLA_IN, DM, GLA_IN, 6144, (bf16*)(ws + WS_WGI) + (size_t)j * GLA_NPAD * DM, scr, gw, ngw, lane);
        transpose_matrix<0>(P.gla_w_out + (size_t)j * GLA_DV * DM, GLA_DV, DM, DM, (bf16*)(ws + WS_WGO) + (size_t)j * DM * GLA_DV, scr, gw, ngw, lane);
        transpose_matrix<0>(P.dil_w_in + (size_t)j * DM * DIL_IN, DM, DIL_IN, DIL_IN, (bf16*)(ws + WS_WDI) + (size_t)j * DIL_IN * DM, scr, gw, ngw, lane);
        transpose_matrix<0>(P.dil_w_out + (size_t)j * DIL_WIDTH * DM, DIL_WIDTH, DM, DM, (bf16*)(ws + WS_WDO) + (size_t)j * DM * DIL_WIDTH, scr, gw, ngw, lane);
    }
    for (int i = 0; i < 4; ++i) {
        transpose_matrix<1>(P.ffn_w_up + (size_t)i * DM * NUP, DM, NUP, NUP, (bf16*)(ws + WS_WUP) + (size_t)i * NUP * DM, scr, gw, ngw, lane);
        transpose_matrix<0>(P.ffn_w_down + (size_t)i * DFF * DM, DFF, DM, DM, (bf16*)(ws + WS_WDN) + (size_t)i * DM * DFF, scr, gw, ngw, lane);
    }
    const size_t gt = (size_t)bx * 512 + tid, ngt = (size_t)G * 512;
    for (size_t idx = gt; idx < (size_t)2 * 256 * DM; idx += ngt) {
        const int j = (int)(idx / (256 * DM)), r = (int)((idx / DM) % 256), k = (int)(idx % DM);
        const float v = r < 16 ? P.gla_w_in[(size_t)j * DM * GLA_IN + (size_t)k * GLA_IN + 6144 + r] : 0.f;
        ((bf16*)(ws + WS_WGI))[(size_t)j * GLA_NPAD * DM + (size_t)(6144 + r) * DM + k] = (bf16)f2bf(v);
    }
    for (size_t idx = gt; idx < (size_t)MTOK * DM / 4; idx += ngt) {
        const f32x4 v = ((const f32x4*)P.x)[idx];
        u32x2 o; o.x = pk2(v[0], v[1]); o.y = pk2(v[2], v[3]);
        ((u32x2*)P.out)[idx] = o;
    }
}

template <bool FINAL>
__device__ __forceinline__ void ln_rows(const short* yq, float* xo, bf16* xb, float* stats, const float* g, const float* b, int gw, int ngw, int lane) {
    f32x4 gv[8], bv[8];
#pragma unroll
    for (int j = 0; j < 4; ++j) { gv[2 * j] = *(const f32x4*)(g + 512 * j + 8 * lane); gv[2 * j + 1] = *(const f32x4*)(g + 512 * j + 8 * lane + 4);
        bv[2 * j] = *(const f32x4*)(b + 512 * j + 8 * lane); bv[2 * j + 1] = *(const f32x4*)(b + 512 * j + 8 * lane + 4); }
#pragma clang loop unroll(disable)
    for (int row = gw; row < MTOK; row += ngw) {
        u32x4 qv[4];
#pragma unroll
        for (int j = 0; j < 4; ++j) qv[j] = *((const u32x4*)(yq + (size_t)row * DM + 512 * j) + lane);
        f32x4 v[8]; float s = 0.f;
#pragma unroll
        for (int j = 0; j < 4; ++j)
#pragma unroll
            for (int i = 0; i < 4; ++i) { const unsigned w = qv[j][i]; const float lo = h_lo(w), hi = h_hi(w);
                v[2 * j + (i >> 1)][2 * (i & 1)] = lo; v[2 * j + (i >> 1)][2 * (i & 1) + 1] = hi; s += lo + hi; }
        const float mean = wave_sum(s) * (1.f / DM); float s2 = 0.f;
#pragma unroll
        for (int j = 0; j < 8; ++j) { v[j] = v[j] - mean; s2 += (v[j][0] * v[j][0] + v[j][1] * v[j][1]) + (v[j][2] * v[j][2] + v[j][3] * v[j][3]); }
        const float rstd = 1.f / sqrtf(wave_sum(s2) * (1.f / DM) + LN_EPS);
        if (FINAL) {
#pragma unroll
            for (int j = 0; j < 4; ++j) { float* xr = xo + (size_t)row * DM + 512 * j + 8 * lane;
                *(f32x4*)xr = v[2 * j] * rstd * gv[2 * j] + bv[2 * j]; *(f32x4*)(xr + 4) = v[2 * j + 1] * rstd * gv[2 * j + 1] + bv[2 * j + 1]; }
        } else {
            if (lane == 0) { stats[2 * row] = mean; stats[2 * row + 1] = rstd; }
#pragma unroll
            for (int j = 0; j < 4; ++j) { const f32x4 o0 = v[2 * j] * rstd * gv[2 * j] + bv[2 * j], o1 = v[2 * j + 1] * rstd * gv[2 * j + 1] + bv[2 * j + 1];
                u32x4 w; w.x = pk2(o0[0], o0[1]); w.y = pk2(o0[2], o0[3]); w.z = pk2(o1[0], o1[1]); w.w = pk2(o1[2], o1[3]);
                *((u32x4*)(xb + (size_t)row * DM + 512 * j) + lane) = w; } }
    }
}
__device__ __forceinline__ void gatenorm_rows(const bf16* o, bf16* oo, const bf16* r, const float* ng, int gw, int ngw, int lane) {
    const f32x4 g0 = ((const f32x4*)ng)[2 * lane], g1 = ((const f32x4*)ng)[2 * lane + 1];
#pragma clang loop unroll(disable)
    for (int row = gw; row < MTOK; row += ngw) {
        u32x4 ov[4], rv[4];
#pragma unroll
        for (int k = 0; k < 4; ++k) { ov[k] = *((const u32x4*)(o + (size_t)row * DM + 512 * k) + lane); rv[k] = *((const u32x4*)(r + (size_t)row * DM + 512 * k) + lane); }
#pragma unroll
        for (int k = 0; k < 4; ++k) {
            float of[8], rf[8];
#pragma unroll
            for (int i = 0; i < 4; ++i) { of[2 * i] = bflo(ov[k][i]); of[2 * i + 1] = bfhi(ov[k][i]); rf[2 * i] = bflo(rv[k][i]); rf[2 * i + 1] = bfhi(rv[k][i]); }
            float ss = 0.f;
#pragma unroll
            for (int i = 0; i < 8; ++i) ss += of[i] * of[i];
            const float rstd = __builtin_amdgcn_rsqf(wave_sum(ss) * (1.f / 512.f) + RMS_EPS);
            float res[8];
#pragma unroll
            for (int i = 0; i < 8; ++i) { const float gg = i < 4 ? g0[i] : g1[i - 4]; const float sl = rf[i] * __builtin_amdgcn_rcpf(1.f + __expf(-rf[i])); res[i] = of[i] * rstd * gg * sl; }
            u32x4 w; w.x = pk2(res[0], res[1]); w.y = pk2(res[2], res[3]); w.z = pk2(res[4], res[5]); w.w = pk2(res[6], res[7]);
            *((u32x4*)(oo + (size_t)row * DM + 512 * k) + lane) = w;
        }
    }
}
__device__ __forceinline__ void combine_rows(const bf16* og, bf16* oo, const float* lse, int gw, int ngw, int lane) {
#pragma clang loop unroll(disable)
    for (int row = gw; row < MTOK; row += ngw) {
        u32x4 a[2], b[2], c[2]; float l0[2], l1[2], l2[2];
#pragma unroll
        for (int k = 0; k < 2; ++k) { const int h = 4 * k + (lane >> 4);
            l0[k] = lse[(size_t)row * 8 + h]; l1[k] = lse[(size_t)MTOK * 8 + (size_t)row * 8 + h]; l2[k] = lse[(size_t)2 * MTOK * 8 + (size_t)row * 8 + h];
            a[k] = *((const u32x4*)(og + (size_t)row * DIL_WIDTH + 512 * k) + lane);
            b[k] = *((const u32x4*)(og + (size_t)MTOK * DIL_WIDTH + (size_t)row * DIL_WIDTH + 512 * k) + lane);
            c[k] = *((const u32x4*)(og + (size_t)2 * MTOK * DIL_WIDTH + (size_t)row * DIL_WIDTH + 512 * k) + lane); }
#pragma unroll
        for (int k = 0; k < 2; ++k) {
            const float mx = fmaxf(l0[k], fmaxf(l1[k], l2[k]));
            float w0 = exp2f(l0[k] - mx), w1 = exp2f(l1[k] - mx), w2 = exp2f(l2[k] - mx); const float inv = 1.f / (w0 + w1 + w2); w0 *= inv; w1 *= inv; w2 *= inv;
            u32x4 w;
#pragma unroll
            for (int i = 0; i < 4; ++i) w[i] = pk2(w0 * bflo(a[k][i]) + w1 * bflo(b[k][i]) + w2 * bflo(c[k][i]), w0 * bfhi(a[k][i]) + w1 * bfhi(b[k][i]) + w2 * bfhi(c[k][i]));
            *((u32x4*)(oo + (size_t)row * DIL_WIDTH + 512 * k) + lane) = w;
        }
    }
}
namespace gla {
typedef short bf16x8 __attribute__((ext_vector_type(8)));
typedef float f32x2 __attribute__((ext_vector_type(2)));
typedef __bf16 bf16x2_t __attribute__((ext_vector_type(2)));
constexpr int BLOB = 74752, OFF_QI = 0, OFF_KT = 32768, OFF_AI = 65536, OFF_DEC = 73728;
__device__ __forceinline__ int swz(int ob) { return ob ^ (((ob >> 9) & 1) << 5); }
__device__ __forceinline__ int img_off(int r, int c, int CT) { return ((r >> 4) * CT + (c >> 5)) * 1024 + swz((r & 15) * 64 + (c & 31) * 2); }
__device__ __forceinline__ unsigned cvtpk(float lo, float hi) { f32x2 v = {lo, hi}; bf16x2_t b = __builtin_convertvector(v, bf16x2_t); return __builtin_bit_cast(unsigned, b); }
__device__ __forceinline__ float logsig(float z) { return fminf(z, 0.f) - 0.6931471805599453f * __builtin_amdgcn_logf(1.f + __builtin_amdgcn_exp2f(-1.4426950408889634f * fabsf(z))); }

__device__ __forceinline__ void prep(LAS unsigned char* lds, const bf16* QK, const bf16* V, const float* GLOW, const float* wgu, const float* gbias, unsigned char* IMG, bf16* VT, int wg, int nwg, int wv) {
    const int tid = fresh_tid(wv), lane = tid & 63, wid = __builtin_amdgcn_readfirstlane(tid >> 6);
    LAS unsigned char* QI = lds; LAS unsigned char* KI = lds + 32768; LAS unsigned char* KT = lds + 65536; LAS unsigned char* AI = lds + 98304;
    LAS float* WG = (LAS float*)(lds + 106496) + wid * 544;
    int hs = -1;
    for (int bi = wg; bi < BATCH * 32 * GLA_H; bi += nwg) {
        const int h = bi & 3, c = (bi >> 2) & 31, b = bi >> 7; const size_t T0 = (size_t)b * SEQ + 64 * c;
        unsigned char* blob = IMG + (size_t)bi * BLOB;
        const int P0 = 32 * wid;
        const size_t row = T0 + lane;
        f32x4 gl[4]; u32x4 qv4[4], kv4[4];
        { const bf16* qrow_ = QK + row * 2048 + 256 * h + P0;
#pragma unroll
          for (int i = 0; i < 4; ++i) gl[i] = *(const f32x4*)(GLOW + row * 16 + 4 * i);
#pragma unroll
          for (int i = 0; i < 4; ++i) { qv4[i] = *(const u32x4*)(qrow_ + 8 * i); kv4[i] = *(const u32x4*)(qrow_ + 1024 + 8 * i); } }
        if (h != hs) { hs = h; const int r = lane >> 2, p8 = 8 * (lane & 3); const float* src_ = wgu + (size_t)r * GLA_DK + 256 * h + P0 + p8;
          const f32x4 a0 = *(const f32x4*)src_, a1 = *(const f32x4*)(src_ + 4);
#pragma unroll
          for (int i = 0; i < 4; ++i) { WG[(p8 + i) * 16 + r] = a0[i]; WG[(p8 + 4 + i) * 16 + r] = a1[i]; }
          if (lane < 32) WG[512 + lane] = gbias[256 * h + P0 + lane]; }
        asm volatile("s_waitcnt lgkmcnt(0)" ::: "memory");
        float bb[32];
        { f32x4 Wa[4], Wb[4]; float Ba, Bb;
#define PREP_LW(W, B, p_) do { _Pragma("unroll") for (int j_ = 0; j_ < 4; ++j_) W[j_] = *(LAS f32x4*)(WG + (p_) * 16 + 4 * j_); B = WG[512 + (p_)]; __builtin_amdgcn_sched_barrier(0); } while (0)
#define PREP_MW(W, B, p_) do { f32x2 za_ = {B, 0.f}, zb_ = {0.f, 0.f}; _Pragma("unroll") for (int i_ = 0; i_ < 4; ++i_) { const f32x4 w_ = W[i_]; za_ = (f32x2){gl[i_][0], gl[i_][1]} * (f32x2){w_[0], w_[1]} + za_; zb_ = (f32x2){gl[i_][2], gl[i_][3]} * (f32x2){w_[2], w_[3]} + zb_; } za_ = za_ + zb_; bb[p_] = za_[0] + za_[1]; __builtin_amdgcn_sched_barrier(0); } while (0)
          PREP_LW(Wa, Ba, 0);
#pragma unroll
          for (int p2 = 0; p2 < 32; p2 += 2) { PREP_LW(Wb, Bb, p2 + 1); PREP_MW(Wa, Ba, p2); if (p2 + 2 < 32) PREP_LW(Wa, Ba, p2 + 2); PREP_MW(Wb, Bb, p2 + 1); }
#undef PREP_LW
#undef PREP_MW
        }
#pragma unroll
        for (int p = 0; p < 32; ++p) {
            const float z = bb[p];
            float v = logsig(z) * 0.0625f;
#define GLA_DPP_ADD(ctrl, rmask) v += __builtin_bit_cast(float, __builtin_amdgcn_update_dpp(0, __builtin_bit_cast(int, v), ctrl, rmask, 0xf, true))
            GLA_DPP_ADD(0x111, 0xf); GLA_DPP_ADD(0x112, 0xf); GLA_DPP_ADD(0x114, 0xf); GLA_DPP_ADD(0x118, 0xf);
            asm volatile("s_nop 1\n\tv_add_f32_dpp %0, %0, %0 row_bcast:15 row_mask:0xa bank_mask:0xf\n\ts_nop 1\n\tv_add_f32_dpp %0, %0, %0 row_bcast:31 row_mask:0xc bank_mask:0xf" : "+v"(v));
#undef GLA_DPP_ADD
            bb[p] = v;
        }
#pragma unroll
        for (int g8 = 0; g8 < 4; ++g8) {
            const u32x4 qv = qv4[g8], kv = kv4[g8];
            float qf[8], kf[8], qo[8], ko[8], ebv[8];
#pragma unroll
            for (int i = 0; i < 4; ++i) { qf[2 * i] = bflo(qv[i]); qf[2 * i + 1] = bfhi(qv[i]); kf[2 * i] = bflo(kv[i]); kf[2 * i + 1] = bfhi(kv[i]); }
#pragma unroll
            for (int i = 0; i < 8; ++i) { const int p = 8 * g8 + i;
                const float eb = __expf(bb[p]), inv = __builtin_amdgcn_rcpf(eb);
                const float ebl = __builtin_bit_cast(float, __builtin_amdgcn_readlane(__builtin_bit_cast(int, eb), 63));
                ebv[i] = eb;
                qo[i] = qf[i] * eb * 0.0625f; ko[i] = kf[i] * inv;
                const int pc = P0 + p, R = (pc & ~31) + 16 * ((pc >> 2) & 1) + 4 * ((pc >> 3) & 3) + (pc & 3);
                *(LAS bf16*)(KT + img_off(R, lane, 2)) = (bf16)(cvtpk(ko[i] * ebl, 0.f) & 0xffffu); }
            u32x4 wq, wk;
#pragma unroll
            for (int i = 0; i < 4; ++i) { wq[i] = cvtpk(qo[2 * i], qo[2 * i + 1]); wk[i] = cvtpk(ko[2 * i], ko[2 * i + 1]); }
            *(LAS u32x4*)(QI + img_off(lane, P0 + 8 * g8, 8)) = wq; *(LAS u32x4*)(KI + img_off(lane, P0 + 8 * g8, 8)) = wk;
            if (lane == 63) {
                *(f32x4*)(blob + OFF_DEC + (P0 + 8 * g8) * 4) = (f32x4){ebv[0], ebv[1], ebv[2], ebv[3]}; *(f32x4*)(blob + OFF_DEC + (P0 + 8 * g8 + 4) * 4) = (f32x4){ebv[4], ebv[5], ebv[6], ebv[7]}; }
        }
        asm volatile("s_waitcnt lgkmcnt(0)" ::: "memory"); __builtin_amdgcn_s_barrier(); asm volatile("" ::: "memory");
        { const int tt = wid >> 1, fo = swz((lane & 15) * 64 + (lane >> 4) * 16);
#pragma unroll
          for (int s2 = 0; s2 < 2; ++s2) { const int st = 2 * (wid & 1) + s2; f32x4 d = (f32x4){0.f, 0.f, 0.f, 0.f};
            if (st <= tt) {
                bf16x8 fa_[8], fk_[8]; f32x4 d2 = (f32x4){0.f, 0.f, 0.f, 0.f};
#pragma unroll
                for (int ks = 0; ks < 8; ++ks) { fa_[ks] = *(LAS bf16x8*)(QI + (tt * 8 + ks) * 1024 + fo); fk_[ks] = *(LAS bf16x8*)(KI + (st * 8 + ks) * 1024 + fo); }
                __builtin_amdgcn_sched_barrier(0);
#pragma unroll
                for (int ks = 0; ks < 8; ks += 2) { d = __builtin_amdgcn_mfma_f32_16x16x32_bf16(fa_[ks], fk_[ks], d, 0, 0, 0); d2 = __builtin_amdgcn_mfma_f32_16x16x32_bf16(fa_[ks + 1], fk_[ks + 1], d2, 0, 0, 0); }
                d = d + d2; }
#pragma unroll
            for (int r = 0; r < 4; ++r) { const int t = 16 * tt + 4 * (lane >> 4) + r, s = 16 * st + (lane & 15); *(LAS bf16*)(AI + img_off(t, s, 2)) = (bf16)f2bf(s <= t ? d[r] : 0.f); } } }
        asm volatile("s_waitcnt lgkmcnt(0)" ::: "memory"); __builtin_amdgcn_s_barrier(); asm volatile("" ::: "memory");
        u32x4 vv_[8];
#pragma unroll
        for (int k = 0; k < 8; ++k) { const int piece = k * 512 + tid, t = piece >> 6, ec = piece & 63; vv_[k] = *(const u32x4*)(V + (T0 + t) * 2048 + 512 * h + 8 * ec); }
#pragma unroll
        for (int k = 0; k < 4; ++k) { const int off = k * 8192 + tid * 16; *(u32x4*)(blob + OFF_QI + off) = *(LAS u32x4*)(QI + off); *(u32x4*)(blob + OFF_KT + off) = *(LAS u32x4*)(KT + off); }
        *(u32x4*)(blob + OFF_AI + tid * 16) = *(LAS u32x4*)(AI + tid * 16);
        asm volatile("s_waitcnt lgkmcnt(0)" ::: "memory"); __builtin_amdgcn_s_barrier(); asm volatile("" ::: "memory");
#pragma unroll
        for (int k = 0; k < 8; ++k) { const int piece = k * 512 + tid, t = piece >> 6, ec = piece & 63; *(LAS u32x4*)(lds + t * 1024 + ((ec ^ ((t >> 3) & 7)) * 16)) = vv_[k]; }
        asm volatile("s_waitcnt lgkmcnt(0)" ::: "memory"); __builtin_amdgcn_s_barrier(); asm volatile("" ::: "memory");
#pragma unroll
        for (int kh = 0; kh < 2; ++kh) {
            unsigned short vv[4][8];
#pragma unroll
            for (int k4 = 0; k4 < 4; ++k4) { const int piece = (4 * kh + k4) * 512 + tid, e = piece >> 3, tc = piece & 7, ec = e >> 3;
#pragma unroll
                for (int i = 0; i < 8; ++i) vv[k4][i] = *(LAS bf16*)(lds + (8 * tc + i) * 1024 + ((ec ^ tc) * 16) + (e & 7) * 2); }
            __builtin_amdgcn_sched_barrier(0);
#pragma unroll
            for (int k4 = 0; k4 < 4; ++k4) { const int piece = (4 * kh + k4) * 512 + tid, e = piece >> 3, tc = piece & 7;
                u32x4 w; w.x = vv[k4][0] | ((unsigned)vv[k4][1] << 16); w.y = vv[k4][2] | ((unsigned)vv[k4][3] << 16); w.z = vv[k4][4] | ((unsigned)vv[k4][5] << 16); w.w = vv[k4][6] | ((unsigned)vv[k4][7] << 16);
                *(u32x4*)(VT + (size_t)bi * 32768 + e * 64 + 8 * tc) = w; } }
        asm volatile("s_waitcnt lgkmcnt(0)" ::: "memory"); __builtin_amdgcn_s_barrier(); asm volatile("" ::: "memory");
    }
}

__device__ __forceinline__ void rec(LAS unsigned char* lds, const unsigned char* IMG, const bf16* VT, bf16* O, int wg, int nwg, int wv) {
    const int tid = fresh_tid(wv), lane = tid & 63, wid = __builtin_amdgcn_readfirstlane(tid >> 6), l15 = lane & 15, q = lane >> 4;
    const int fo = swz(l15 * 64 + q * 16);
    for (int item = wg; item < BATCH * GLA_H * 4; item += nwg) {
        const int j = item & 3, h = (item >> 2) & 3, b = item >> 4, E0 = 128 * j + 16 * wid;
        f32x4 S[16];
#pragma unroll
        for (int i = 0; i < 16; ++i) S[i] = (f32x4){0.f, 0.f, 0.f, 0.f};
        const size_t bi0 = (size_t)(b * 32) * 4 + h;
#define GLA_DMA(c_, buf_) do { const unsigned char* src_ = IMG + (bi0 + 4 * (size_t)(c_)) * BLOB; \
        for (int pc_ = wid; pc_ < 73; pc_ += 8) __builtin_amdgcn_global_load_lds((const unsigned*)(src_ + pc_ * 1024 + lane * 16), (LAS unsigned*)((buf_) + pc_ * 1024), 16, 0, 0); } while (0)
#define GLA_VT(c_, dst_) do { const bf16* vp_ = VT + (bi0 + 4 * (size_t)(c_)) * 32768 + (size_t)(E0 + l15) * 64 + 8 * q; dst_[0] = *(const bf16x8*)vp_; dst_[1] = *(const bf16x8*)(vp_ + 32); } while (0)
        bf16x8 vt[2], vtn[2];
        GLA_DMA(0, lds); GLA_VT(0, vt);
        asm volatile("s_waitcnt vmcnt(0)" ::: "memory"); __builtin_amdgcn_s_barrier(); asm volatile("" ::: "memory");
        for (int c = 0; c < 32; ++c) {
            LAS unsigned char* cur = lds + (c & 1) * BLOB; LAS unsigned char* nxt = lds + ((c + 1) & 1) * BLOB;
            vtn[0] = vt[0]; vtn[1] = vt[1];
            if (c + 1 < 32) { GLA_DMA(c + 1, nxt); GLA_VT(c + 1, vtn); }
            bf16x8 Sf[8];
#pragma unroll
            for (int ks = 0; ks < 8; ++ks) { u32x4 w; w.x = cvtpk(S[2 * ks][0], S[2 * ks][1]); w.y = cvtpk(S[2 * ks][2], S[2 * ks][3]); w.z = cvtpk(S[2 * ks + 1][0], S[2 * ks + 1][1]); w.w = cvtpk(S[2 * ks + 1][2], S[2 * ks + 1][3]);
                Sf[ks] = __builtin_bit_cast(bf16x8, w); }
            f32x4 o[4];
#pragma unroll
            for (int tt = 0; tt < 4; ++tt) o[tt] = (f32x4){0.f, 0.f, 0.f, 0.f};
            const LAS unsigned char* fb_ = cur + fo;
            u32x4 F0[8], F1[8];
#define REC_SB() __builtin_amdgcn_sched_barrier(0)
#define REC_LQ(F, kb) do { _Pragma("unroll") for (int j_ = 0; j_ < 8; ++j_) F[j_] = *(const LAS u32x4*)(fb_ + OFF_QI + ((j_ & 3) * 8 + 2 * (kb) + (j_ >> 2)) * 1024); REC_SB(); } while (0)
#define REC_MQ(F, kb) do { _Pragma("unroll") for (int j_ = 0; j_ < 8; ++j_) o[j_ & 3] = __builtin_amdgcn_mfma_f32_16x16x32_bf16(Sf[2 * (kb) + (j_ >> 2)], __builtin_bit_cast(bf16x8, F[j_]), o[j_ & 3], 0, 0, 0); REC_SB(); } while (0)
#define REC_LA(F) do { _Pragma("unroll") for (int j_ = 0; j_ < 8; ++j_) F[j_] = *(const LAS u32x4*)(fb_ + OFF_AI + ((j_ & 3) * 2 + (j_ >> 2)) * 1024); REC_SB(); } while (0)
#define REC_MA(F) do { _Pragma("unroll") for (int j_ = 0; j_ < 8; ++j_) o[j_ & 3] = __builtin_amdgcn_mfma_f32_16x16x32_bf16(vt[j_ >> 2], __builtin_bit_cast(bf16x8, F[j_]), o[j_ & 3], 0, 0, 0); REC_SB(); } while (0)
#define REC_LD(F, d) do { _Pragma("unroll") for (int j_ = 0; j_ < 8; ++j_) { const int i_ = 8 * (d) + j_; F[j_] = *(const LAS u32x4*)(cur + OFF_DEC + (32 * (i_ >> 1) + 8 * q + 4 * (i_ & 1)) * 4); } REC_SB(); } while (0)
#define REC_MD(F, d) do { _Pragma("unroll") for (int j_ = 0; j_ < 8; ++j_) S[8 * (d) + j_] = S[8 * (d) + j_] * __builtin_bit_cast(f32x4, F[j_]); REC_SB(); } while (0)
#define REC_LK(F, n) do { _Pragma("unroll") for (int j_ = 0; j_ < 8; ++j_) F[j_] = *(const LAS u32x4*)(fb_ + OFF_KT + ((8 * ((n) & 1) + j_) * 2 + ((n) >> 1)) * 1024); REC_SB(); } while (0)
#define REC_MK(F, n) do { _Pragma("unroll") for (int j_ = 0; j_ < 8; ++j_) S[8 * ((n) & 1) + j_] = __builtin_amdgcn_mfma_f32_16x16x32_bf16(__builtin_bit_cast(bf16x8, F[j_]), vt[(n) >> 1], S[8 * ((n) & 1) + j_], 0, 0, 0); REC_SB(); } while (0)
            REC_SB();
            REC_LQ(F0, 0);
            REC_LQ(F1, 1); REC_MQ(F0, 0);
            REC_LQ(F0, 2); REC_MQ(F1, 1);
            REC_LQ(F1, 3); REC_MQ(F0, 2);
            REC_LA(F0);    REC_MQ(F1, 3);
            REC_LD(F1, 0); REC_MA(F0);
            { const size_t row0 = (size_t)b * SEQ + 64 * c + l15;
#pragma unroll
              for (int tt = 0; tt < 4; ++tt) { u32x2 w; w.x = cvtpk(o[tt][0], o[tt][1]); w.y = cvtpk(o[tt][2], o[tt][3]); *(u32x2*)(O + (row0 + 16 * tt) * 2048 + 512 * h + E0 + 4 * q) = w; } }
            REC_SB();
            REC_LD(F0, 1); REC_MD(F1, 0);
            REC_LK(F1, 0); REC_MD(F0, 1);
            REC_LK(F0, 1); REC_MK(F1, 0);
            REC_LK(F1, 2); REC_MK(F0, 1);
            REC_LK(F0, 3); REC_MK(F1, 2);
                           REC_MK(F0, 3);
#undef REC_SB
#undef REC_LQ
#undef REC_MQ
#undef REC_LA
#undef REC_MA
#undef REC_LD
#undef REC_MD
#undef REC_LK
#undef REC_MK
            asm volatile("s_waitcnt vmcnt(4) lgkmcnt(0)" ::: "memory"); __builtin_amdgcn_s_barrier(); asm volatile("" ::: "memory");
            vt[0] = vtn[0]; vt[1] = vtn[1];
        }
#undef GLA_DMA
#undef GLA_VT
    }
}
}

namespace swa {
typedef short bf16x8 __attribute__((ext_vector_type(8)));
typedef short s16x4 __attribute__((ext_vector_type(4)));
typedef float f32x16 __attribute__((ext_vector_type(16)));
constexpr int D = 128, NW = 8, QBLK = 32, KVBLK = 64, QB = NW * QBLK, W = 129;
constexpr int SHM_V = KVBLK * D * 2, SHM_K = KVBLK * D * 2;
constexpr int LDS_NEED = 2 * SHM_V + 2 * SHM_K + NW * 64 * 4;
constexpr int OSTG_OFF = 69632, OSTG_PITCH = 272, OSTG_WAVE = 32 * OSTG_PITCH;
static_assert(OSTG_OFF >= LDS_NEED && OSTG_OFF + NW * OSTG_WAVE <= 155648 - 256, "O staging inside the workgroup's LDS, clear of the control words");
constexpr float SCALE = 0.08838834764831845f, THR = 8.f;
constexpr int RS = DIL_IN, ORS = DIL_WIDTH, LRS = DIL_HEADS;
constexpr bool SK = true;
#define KSWZ(row, colB) ((row) * 256 + ((colB) ^ (((row) & 7) << 4)))
#define SBAR() __builtin_amdgcn_sched_barrier(0)
__device__ __forceinline__ int v_st(int k, int c) { const int kk = (k & ~0xC) | ((k & 4) << 1) | ((k & 8) >> 1); return ((kk >> 3) * 4 + (c >> 5)) * 512 + ((kk & 7) * 32 + (c & 31)) * 2; }
__device__ __forceinline__ int v_rd_base(int lane) { return ((lane & 3) << 3) | (((lane >> 2) & 3) << 6) | (((lane >> 4) & 1) << 5) | (((lane >> 5) & 1) << 8); }
constexpr int v_rd_off(int d0, int ks, int half) { return d0 * 512 + ks * 4096 + half * 2048; }
__device__ __forceinline__ int crow(int r, int hi) { return (r & 3) + 8 * (r >> 2) + 4 * hi; }
__device__ __forceinline__ unsigned cvtpk(float lo, float hi) { unsigned r; asm volatile("v_cvt_pk_bf16_f32 %0, %1, %2" : "=v"(r) : "v"(lo), "v"(hi)); return r; }
__device__ __forceinline__ bf16x8 load8(const bf16* p) { return *reinterpret_cast<const bf16x8*>(p); }
__device__ __forceinline__ void mask_tile(f32x16& p0, f32x16& p1, int dq, unsigned Wl) {
    const float NEG = -__builtin_inff();
#pragma unroll
    for (int r = 0; r < 16; ++r) { const int c = (r & 3) + 8 * (r >> 2);
        if ((unsigned)(dq - c) >= Wl) p0[r] = NEG;
        if ((unsigned)(dq - c - 32) >= Wl) p1[r] = NEG; }
}
__device__ __forceinline__ void partialSM(f32x16& p0, f32x16& p1, float& m_reg, float& mn, float& alpha) {
    float pmax = p0[0]; for (int r = 1; r < 16; ++r) pmax = fmaxf(pmax, p0[r]); for (int r = 0; r < 16; ++r) pmax = fmaxf(pmax, p1[r]);
    { auto rr = __builtin_amdgcn_permlane32_swap(__float_as_uint(pmax), __float_as_uint(pmax), false, false);
      pmax = fmaxf(__uint_as_float(rr[0]), __uint_as_float(rr[1])); }
    constexpr float C2 = 1.4426950408889634f * SCALE;
    if (__builtin_expect(__all((pmax - m_reg) * SCALE <= THR), 1)) { mn = m_reg; alpha = 1.f; }
    else { mn = fmaxf(m_reg, pmax); alpha = __builtin_amdgcn_exp2f((m_reg - mn) * C2); m_reg = mn; }
    const float mnL = -mn * C2;
    for (int r = 0; r < 16; ++r) p0[r] = fmaf(p0[r], C2, mnL); for (int r = 0; r < 16; ++r) p1[r] = fmaf(p1[r], C2, mnL);
    for (int r = 0; r < 16; ++r) p0[r] = __builtin_amdgcn_exp2f(p0[r]);
}
__device__ __forceinline__ void finishSM(f32x16& p0, f32x16& p1, float alpha, float& l_reg, bf16x8& pa0, bf16x8& pa1, bf16x8& pa2, bf16x8& pa3) {
    for (int r = 0; r < 16; ++r) p1[r] = __builtin_amdgcn_exp2f(p1[r]);
    float ps = 0; for (int r = 0; r < 16; ++r) ps += p0[r]; for (int r = 0; r < 16; ++r) ps += p1[r];
    { auto rr = __builtin_amdgcn_permlane32_swap(__float_as_uint(ps), __float_as_uint(ps), false, false);
      ps = __uint_as_float(rr[0]) + __uint_as_float(rr[1]); }
    l_reg = l_reg * alpha + ps;
#define PK4(P, B_, OUT) do { unsigned a0 = cvtpk(P[B_+0], P[B_+1]), a1 = cvtpk(P[B_+2], P[B_+3]);                          \
        unsigned b0 = cvtpk(P[B_+4], P[B_+5]), b1 = cvtpk(P[B_+6], P[B_+7]);                                             \
        auto r0 = __builtin_amdgcn_permlane32_swap(a0, b0, false, false); auto r1 = __builtin_amdgcn_permlane32_swap(a1, b1, false, false); \
        u32x4 w = {r0[0], r1[0], r0[1], r1[1]}; OUT = *reinterpret_cast<bf16x8*>(&w); } while (0)
    PK4(p0, 0, pa0); PK4(p0, 8, pa1); PK4(p1, 0, pa2); PK4(p1, 8, pa3);
#undef PK4
}
template <int KB>
__device__ __forceinline__ void qkt(f32x16& p0, f32x16& p1, const char* K_lds, int r32, int hi, const bf16x8* qr, bool act) {
    if (SK && !act) { const float NEG = -__builtin_inff();
#pragma unroll
        for (int r = 0; r < 16; ++r) { p0[r] = NEG; p1[r] = NEG; } return; }
    p0 = f32x16{}; p1 = f32x16{};
    const char* kb[4];
#pragma unroll
    for (int dd = 0; dd < 4; ++dd) kb[dd] = K_lds + KB * SHM_K + KSWZ(r32, (dd * 16 + hi * 8) * 2);
#define QKT_LD(x, y, d0) do { const char* a_ = kb[(d0) & 3] + ((d0) >> 2) * 128; x = *reinterpret_cast<const bf16x8*>(a_); y = *reinterpret_cast<const bf16x8*>(a_ + 32 * 256); } while (0)
#define QKT_MM(x, y, d0) do { p0 = __builtin_amdgcn_mfma_f32_32x32x16_bf16(x, qr[d0], p0, 0, 0, 0); p1 = __builtin_amdgcn_mfma_f32_32x32x16_bf16(y, qr[d0], p1, 0, 0, 0); } while (0)
    bf16x8 xa, ya, xb, yb, xc, yc;
    QKT_LD(xa, ya, 0); QKT_LD(xb, yb, 1); SBAR();
    QKT_LD(xc, yc, 2); SBAR(); QKT_MM(xa, ya, 0); SBAR();
    QKT_LD(xa, ya, 3); SBAR(); QKT_MM(xb, yb, 1); SBAR();
    QKT_LD(xb, yb, 4); SBAR(); QKT_MM(xc, yc, 2); SBAR();
    QKT_LD(xc, yc, 5); SBAR(); QKT_MM(xa, ya, 3); SBAR();
    QKT_LD(xa, ya, 6); SBAR(); QKT_MM(xb, yb, 4); SBAR();
    QKT_LD(xb, yb, 7); SBAR(); QKT_MM(xc, yc, 5); SBAR();
    QKT_MM(xa, ya, 6); SBAR(); QKT_MM(xb, yb, 7); SBAR();
#undef QKT_LD
#undef QKT_MM
}
template <int VB>
__device__ __forceinline__ void pv_tile(f32x16* o, int vb0, bf16x8 pa0, bf16x8 pa1, bf16x8 pa2, bf16x8 pa3, bool act) {
    if (SK && !act) return;
#define TRRD(dst, off) asm volatile("ds_read_b64_tr_b16 %0, %1 offset:%2" : "=&v"(dst) : "v"(vb0), "i"(off) : "memory")
#define PV_D0(d0) do { s16x4 l0, l1, l2, l3, h0, h1, h2, h3; constexpr int b_ = VB * SHM_V + v_rd_off(d0, 0, 0); \
        TRRD(l0, b_); TRRD(h0, b_ + 2048); TRRD(l1, b_ + 4096); TRRD(h1, b_ + 6144); TRRD(l2, b_ + 8192); TRRD(h2, b_ + 10240); TRRD(l3, b_ + 12288); TRRD(h3, b_ + 14336); \
        asm volatile("s_waitcnt lgkmcnt(0)" ::: "memory"); SBAR();   \
        o[d0] = __builtin_amdgcn_mfma_f32_32x32x16_bf16(pa0, (bf16x8){l0[0], l0[1], l0[2], l0[3], h0[0], h0[1], h0[2], h0[3]}, o[d0], 0, 0, 0);   \
        o[d0] = __builtin_amdgcn_mfma_f32_32x32x16_bf16(pa1, (bf16x8){l1[0], l1[1], l1[2], l1[3], h1[0], h1[1], h1[2], h1[3]}, o[d0], 0, 0, 0);   \
        o[d0] = __builtin_amdgcn_mfma_f32_32x32x16_bf16(pa2, (bf16x8){l2[0], l2[1], l2[2], l2[3], h2[0], h2[1], h2[2], h2[3]}, o[d0], 0, 0, 0);   \
        o[d0] = __builtin_amdgcn_mfma_f32_32x32x16_bf16(pa3, (bf16x8){l3[0], l3[1], l3[2], l3[3], h3[0], h3[1], h3[2], h3[3]}, o[d0], 0, 0, 0); } while (0)
    PV_D0(0); PV_D0(1); PV_D0(2); PV_D0(3);
#undef PV_D0
#undef TRRD
}
struct BlockRef { const bf16* Q; const bf16* K; const bf16* V; bf16* O; float* L; int P0, sh, msk, dil, segmask, skv; };
struct Seam { bf16x8 qr[8]; bf16x8 st_v0, st_v1, st_k0, st_k1; };
__device__ __forceinline__ int rowoff(const BlockRef& r, int pos) { return (pos >> r.sh) + (pos & r.msk) * r.dil; }
__device__ __forceinline__ int swa_jlo(int P0) { const int lowk = P0 - W + 1; return lowk > 0 ? lowk / KVBLK : 0; }
#define VMW() asm volatile("s_waitcnt vmcnt(0)" ::: "memory")
#define VMWN(n) asm volatile("s_waitcnt vmcnt(%0)" :: "i"(n) : "memory")
#define SLOAD_H(ref, k0) do { const size_t r0_ = (size_t)rowoff(ref, (k0) + sr) * RS + sc, r1_ = (size_t)rowoff(ref, (k0) + 32 + sr) * RS + sc; \
                         S.st_v0 = load8((ref).V + r0_); S.st_v1 = load8((ref).V + r1_); S.st_k0 = load8((ref).K + r0_); S.st_k1 = load8((ref).K + r1_); } while (0)
#define SWRITE_HK(bf) do { *(bf16x8*)(K_lds + (bf) * SHM_K + kws) = S.st_k0; *(bf16x8*)(K_lds + (bf) * SHM_K + kws + 32 * 256) = S.st_k1; } while (0)
#define SWRITE_HV(bf) do { *(bf16x8*)(V_lds + (bf) * SHM_V + vst0) = S.st_v0; *(bf16x8*)(V_lds + (bf) * SHM_V + vst1) = S.st_v1; } while (0)
#define SWRITE_H(bf) do { SWRITE_HV(bf); SWRITE_HK(bf); } while (0)
__device__ __forceinline__ void prime(const BlockRef& cur, char* lds, Seam& S, int wv) {
    const int tid = fresh_tid(wv), wid = __builtin_amdgcn_readfirstlane(tid >> 6), lane = tid & 63, r32 = lane & 31, hi = lane >> 5;
    const int sr = tid >> 4, sc = (tid & 15) * 8, kws = KSWZ(sr, sc * 2); char* K_lds = lds + 2 * SHM_V;
    const int kb0 = swa_jlo(cur.P0) * KVBLK;
    const bf16* qrow = cur.Q + (size_t)rowoff(cur, cur.P0 + wid * QBLK + r32) * RS;
    for (int d0 = 0; d0 < 8; ++d0) S.qr[d0] = load8(qrow + d0 * 16 + hi * 8);
    SLOAD_H(cur, kb0); VMW(); SWRITE_HK(0);
    __syncthreads();
}
__device__ __forceinline__ void block(const BlockRef& cur, const BlockRef& nxt, char* lds, Seam& S, int wv) {
    const int tid = fresh_tid(wv), wid = __builtin_amdgcn_readfirstlane(tid >> 6), lane = tid & 63, r32 = lane & 31, hi = lane >> 5;
    const int j_lo = swa_jlo(cur.P0);
    int j_hi = (cur.P0 + QB - 1) / KVBLK + 1; if (j_hi > cur.skv / KVBLK) j_hi = cur.skv / KVBLK;
    const int NT = j_hi - j_lo;
    const int kbn = swa_jlo(nxt.P0) * KVBLK;
    const int qlo = cur.P0 + wid * QBLK, qm = qlo + r32 - 4 * hi;
    const int segst = qlo & ~cur.segmask;
    const int lowk = (qlo - W + 1) > segst ? (qlo - W + 1) : segst;
    const unsigned Wl = (unsigned)((((qlo + r32) & cur.segmask) + 1) < W ? (((qlo + r32) & cur.segmask) + 1) : W);
    char* V_lds = lds; char* K_lds = lds + 2 * SHM_V;
    float* ws = (float*)(lds + 2 * SHM_V + 2 * SHM_K) + wid * 64; float* li_l = ws, * al_l = ws + 32;
    float m_reg = -1e30f, l_reg = 0; f32x16 o[4] = {};
    const int sr = tid >> 4, sc = (tid & 15) * 8, vst0 = v_st(sr, sc), vst1 = v_st(32 + sr, sc), kws = KSWZ(sr, sc * 2);
    const int vb0 = (int)(uintptr_t)V_lds + v_rd_base(lane);
#define RESC(a) do { if (__any((a) < 1.f)) { if (hi == 0) al_l[r32] = (a); asm volatile("s_waitcnt lgkmcnt(0)" ::: "memory");              \
                     for (int d_ = 0; d_ < 4; ++d_) for (int r = 0; r < 16; ++r) o[d_][r] *= al_l[crow(r, hi)]; } } while (0)
#define KBASE(t) ((j_lo + (t)) * KVBLK)
#define ACT(t) (KBASE(t) <= qlo + QBLK - 1 && KBASE(t) + KVBLK - 1 >= lowk)
#define MASKT(P0_, P1_, t) do { const int kb_ = KBASE(t); if ((!SK || ACT(t)) && (kb_ + KVBLK - 1 > qlo || kb_ <= qlo + QBLK - 1 - W || kb_ < segst)) mask_tile(P0_, P1_, qm - kb_, Wl); } while (0)
    constexpr int NQL = 8;
#define SEAM_K0() do { VMWN(NQL); SWRITE_HK(0); SBAR(); } while (0)
    f32x16 pA0, pA1, pB0, pB1; float mnA, mnB, alA, alB; bf16x8 pa0, pa1, pa2, pa3;
    SWRITE_HV(0); SBAR();
    if (NT > 1) { SLOAD_H(cur, KBASE(1)); }
    SBAR(); qkt<0>(pA0, pA1, K_lds, r32, hi, S.qr, ACT(0));
    MASKT(pA0, pA1, 0); partialSM(pA0, pA1, m_reg, mnA, alA);
    if (NT > 1) { VMW(); SWRITE_H(1); }
    __syncthreads();
#define HALF_STEP(PX0, PX1, mnX, alX, PY0, PY1, alY, t, KB, VB, SB) do {                                                      \
        SBAR(); qkt<KB>(PX0, PX1, K_lds, r32, hi, S.qr, ACT(t));                                             \
        finishSM(PY0, PY1, alY, l_reg, pa0, pa1, pa2, pa3); SBAR();                                                           \
        if ((t) + 1 < NT) { SLOAD_H(cur, KBASE((t) + 1)); SBAR(); }                                               \
        pv_tile<VB>(o, vb0, pa0, pa1, pa2, pa3, ACT((t) - 1)); MASKT(PX0, PX1, (t)); partialSM(PX0, PX1, m_reg, mnX, alX);                                        \
        __syncthreads();                                                                                                      \
        if ((t) + 1 < NT) { VMW(); SWRITE_H(SB); }                                                                          \
        RESC(alX); __syncthreads(); } while (0)
    for (int t = 1; t + 1 < NT; t += 2) {
        HALF_STEP(pB0, pB1, mnB, alB, pA0, pA1, alA, t, 1, 0, 0);
        HALF_STEP(pA0, pA1, mnA, alA, pB0, pB1, alB, t + 1, 0, 1, 1);
    }
    const bool even = (NT & 1) == 0;
    if (even) { SBAR(); qkt<1>(pB0, pB1, K_lds, r32, hi, S.qr, ACT(NT - 1)); SBAR(); }
    { SLOAD_H(nxt, kbn); SBAR();
      const bf16* qrow = nxt.Q + (size_t)rowoff(nxt, nxt.P0 + wid * QBLK + r32) * RS;
#pragma unroll
      for (int d0 = 0; d0 < 8; ++d0) S.qr[d0] = load8(qrow + d0 * 16 + hi * 8); }
    SBAR();
    finishSM(pA0, pA1, alA, l_reg, pa0, pa1, pa2, pa3); SBAR();
    pv_tile<0>(o, vb0, pa0, pa1, pa2, pa3, ACT(even ? NT - 2 : NT - 1));
    if (even) { MASKT(pB0, pB1, NT - 1); partialSM(pB0, pB1, m_reg, mnB, alB); __syncthreads(); RESC(alB);
        finishSM(pB0, pB1, alB, l_reg, pa0, pa1, pa2, pa3); SBAR(); pv_tile<1>(o, vb0, pa0, pa1, pa2, pa3, ACT(NT - 1)); }
    SBAR(); SEAM_K0();
    if (hi == 0) { li_l[r32] = l_reg; cur.L[(size_t)rowoff(cur, qlo + r32) * LRS] = m_reg * (1.4426950408889634f * SCALE) + __log2f(l_reg); }
    asm volatile("s_waitcnt lgkmcnt(0)" ::: "memory");
    float rli[16];
#pragma unroll
    for (int r = 0; r < 16; ++r) rli[r] = __builtin_amdgcn_rcpf(li_l[crow(r, hi)]);
    { char* stg = lds + OSTG_OFF + wid * OSTG_WAVE;
#pragma unroll
      for (int r = 0; r < 16; ++r) { char* rp = stg + crow(r, hi) * OSTG_PITCH + r32 * 2;
#pragma unroll
          for (int d0 = 0; d0 < 4; ++d0) *(unsigned short*)(rp + d0 * 64) = (unsigned short)cvtpk(o[d0][r] * rli[r], 0.f); }
      asm volatile("s_waitcnt lgkmcnt(0)" ::: "memory");
#pragma unroll
      for (int k = 0; k < 8; ++k) { const int row = 4 * k + (lane >> 4), ch = lane & 15;
          const u32x4 v = *(const u32x4*)(stg + row * OSTG_PITCH + ch * 16);
          *(u32x4*)(cur.O + (size_t)rowoff(cur, qlo + row) * ORS + ch * 8) = v; } }
    asm volatile("s_waitcnt lgkmcnt(0)" ::: "memory"); __syncthreads();
#undef RESC
#undef KBASE
#undef ACT
#undef MASKT
#undef SEAM_K0
#undef HALF_STEP
}
#undef VMW
#undef VMWN
#undef SLOAD_H
#undef SWRITE_HK
#undef SWRITE_HV
#undef SWRITE_H
__device__ __forceinline__ BlockRef decode(int L, const bf16* PROJ, bf16* OG, float* LSE) {
    const int g = L >> 10, idx = L & 1023, b = idx >> 6; BlockRef r; int base, h;
    if (g == 0) { h = (idx >> 3) & 7; const int qb = ((idx & 7) + (idx >> 8)) & 7; base = b * SEQ; r.P0 = QB * qb; r.sh = 30; r.msk = 0x3fffffff; r.dil = 1; r.segmask = 0x7fffffff; r.skv = 2048; }
    else if (g == 1) { const int res = (idx >> 4) & 3; h = (idx >> 1) & 7; base = b * SEQ + res; r.P0 = QB * ((idx ^ (idx >> 8)) & 1); r.sh = 30; r.msk = 0x3fffffff; r.dil = 4; r.segmask = 0x7fffffff; r.skv = 512; }
    else { const int pair = (idx >> 3) & 7; h = idx & 7; base = b * SEQ + 2 * pair; r.P0 = 0; r.sh = 7; r.msk = 127; r.dil = 16; r.segmask = 127; r.skv = 256; }
    r.Q = PROJ + (size_t)base * RS + g * 3072 + h * 128; r.K = r.Q + 1024; r.V = r.Q + 2048;
    r.O = OG + (size_t)g * MTOK * ORS + (size_t)base * ORS + h * 128; r.L = LSE + (size_t)g * MTOK * LRS + (size_t)base * LRS + h;
    return r;
}
__device__ __forceinline__ void phase(char* lds, const bf16* PROJ, bf16* OG, float* LSE, int wg, int nwg, int wv) {
    constexpr int total = 3 * 1024;
    int L = wg; if (L >= total) return;
    BlockRef cur = decode(L, PROJ, OG, LSE);
    Seam S;
    prime(cur, lds, S, wv);
    for (;;) {
        const bool more = L + nwg < total;
        const BlockRef nxt = more ? decode(L + nwg, PROJ, OG, LSE) : cur;
        block(cur, nxt, lds, S, wv);
        if (!more) break;
        cur = nxt; L += nwg;
    }
}
#undef KSWZ
#undef SBAR
}

__device__ __forceinline__ void ffn_fixup(const float* HALO, bf16* ACT, const float* cw, const float* cb, int gt, int ngt) {
    for (int idx = gt; idx < (MTOK / 256) * DFF; idx += ngt) {
        const int pm = idx / DFF, c = idx % DFF, sg = 256 * (c / 128) + (c % 128);
        const float* h = HALO + (size_t)pm * 4 * NUP;
        const bool first = (pm & 7) == 0;
        float res[2][2];
#pragma unroll
        for (int bj = 0; bj < 2; ++bj) {
            const int col = bj * DFF + c, s = sg + 128 * bj;
            const float w0 = cw[col], w1 = cw[NUP + col], w2 = cw[2 * NUP + col], bb = cb[col];
            const float p2 = first ? 0.f : h[-2 * NUP + s], p1 = first ? 0.f : h[-1 * NUP + s], h0 = h[s], h1 = h[NUP + s];
            res[bj][0] = w0 * p2 + w1 * p1 + w2 * h0 + bb; res[bj][1] = w0 * p1 + w1 * h0 + w2 * h1 + bb;
        }
#pragma unroll
        for (int r = 0; r < 2; ++r) { const float g = res[0][r]; ACT[(size_t)(pm * 256 + r) * DFF + c] = (bf16)f2bf(g / (1.f + __expf(-g)) * res[1][r]); }
    }
}

#define XB_TMO      128
#define XB_XCNT(j)  (256  + 64 * (j))
#define XB_XSUB(j)  (1280 + 64 * (j))
#define XB_XGEN(j)  (2304 + 64 * (j))
#define XB_TOP      3328
#define XB_TOPGEN   3392
#define XCD_BAR_WORDS 3456
#define XB_SPIN_CAP (1u << 18)
__device__ __forceinline__ unsigned xb_ld(unsigned* p)              { return __hip_atomic_load(p, __ATOMIC_RELAXED, __HIP_MEMORY_SCOPE_AGENT); }
__device__ __forceinline__ unsigned xb_add(unsigned* p, unsigned v) { return __hip_atomic_fetch_add(p, v, __ATOMIC_RELAXED, __HIP_MEMORY_SCOPE_AGENT); }
__device__ __forceinline__ unsigned xb_xcc_id() { return (unsigned)__builtin_amdgcn_s_getreg((3 << 11) | 20) & 0xFu; }
#define XB_SPIN(cond, bar) do { unsigned _sp = 0; while (cond) { __builtin_amdgcn_s_sleep(1); \
    if ((++_sp & 255u) == 0u) { if (xb_ld(&(bar)[XB_TMO])) break; if (_sp > XB_SPIN_CAP) { atomicAdd(&(bar)[XB_TMO], 1u); break; } } } } while (0)
struct XcdBarrier { unsigned* bar; unsigned x; volatile LAS unsigned* st; };
__device__ __forceinline__ XcdBarrier xcd_barrier_post(unsigned* bar, volatile LAS unsigned* st) {
    XcdBarrier b; b.bar = bar; b.x = xb_xcc_id(); b.st = st;
    if (threadIdx.x == 0) (void)xb_add(&bar[XB_XCNT(b.x)], 1u);
    return b;
}
__device__ __forceinline__ void xcd_barrier_complete(unsigned* bar, unsigned x, unsigned& nloc, unsigned& nx) {
    const unsigned G = gridDim.x * gridDim.y * gridDim.z;
    unsigned sum, cnt, mine, sp = 0u;
    for (;;) {
        sum = 0u; cnt = 0u; mine = 0u;
#pragma unroll
        for (unsigned j = 0; j < 16; ++j) { const unsigned c = xb_ld(&bar[XB_XCNT(j)]); sum += c; cnt += (c > 0u) ? 1u : 0u; mine = (j == x) ? c : mine; }
        if (sum == G) break;
        __builtin_amdgcn_s_sleep(1);
        if ((++sp & 255u) == 0u) { if (xb_ld(&bar[XB_TMO])) break; if (sp > XB_SPIN_CAP) { atomicAdd(&bar[XB_TMO], 1u); break; } }
    }
    nloc = mine > 0u ? mine : 1u; nx = cnt > 0u ? cnt : 1u;
}
__device__ __forceinline__ void xcd_barrier(const XcdBarrier& b, int wv) {
    asm volatile("s_waitcnt vmcnt(0)" ::: "memory");
    __syncthreads();
    if (fresh_tid(wv) == 0) {
        unsigned* bar = b.bar;
        __builtin_amdgcn_s_waitcnt(0);
        unsigned nloc = b.st[0], nx = b.st[1];
        if (nloc == 0u) { xcd_barrier_complete(bar, b.x, nloc, nx); b.st[0] = nloc; b.st[1] = nx; }
        const unsigned old = xb_add(&bar[XB_XSUB(b.x)], 1u);
        const unsigned gen = old / nloc;
        if (old + 1u == (gen + 1u) * nloc) {
            __builtin_amdgcn_fence(__ATOMIC_RELEASE, "agent");
            asm volatile("s_waitcnt vmcnt(0)" ::: "memory");
            const unsigned og = xb_add(&bar[XB_TOP], 1u);
            const unsigned tg = og / nx;
            if (og + 1u == (tg + 1u) * nx) xb_add(&bar[XB_TOPGEN], 1u);
            else XB_SPIN(xb_ld(&bar[XB_TOPGEN]) == tg, bar);
            __builtin_amdgcn_fence(__ATOMIC_ACQUIRE, "agent");
            xb_add(&bar[XB_XGEN(b.x)], 1u);
            asm volatile("s_waitcnt vmcnt(0)" ::: "memory");
        } else {
            XB_SPIN(xb_ld(&bar[XB_XGEN(b.x)]) == gen, bar);
            __builtin_amdgcn_fence(__ATOMIC_ACQUIRE, "agent");
            asm volatile("s_waitcnt vmcnt(0)" ::: "memory");
        }
    }
    __syncthreads();
}

constexpr int LDS_BYTES = 155648, MISC_OFF = LDS_BYTES - 256, N_PHASES = 41;
constexpr int CW_BAR = 4096;
constexpr size_t CTL_ZERO_BYTES = 65536;
#ifndef MK_CUTS
#define MK_CUTS 0
#endif
struct Args { Params P; int ph_lo, ph_hi; };
#define REP_PRO 1
#define REP_GIN 1
#define REP_PREP 1
#define REP_REC 1
#define REP_GN 1
#define REP_OUT 1
#define REP_SWA 1
#define REP_COMB 1
#define REP_LN 1
#define REP_UP 1
#define REP_FIX 1
#define REP_DOWN 1
constexpr size_t WS_DUMMY = WS_REG + 400 * MiB;
typedef const __attribute__((address_space(4))) Args* KArgs;
#define KARGS(ap) KArgs ap = (KArgs)__builtin_amdgcn_kernarg_segment_ptr(); asm volatile("" : "+s"(ap))
__global__ void __launch_bounds__(512, 2) mega(Args a) {
    extern __shared__ __attribute__((aligned(16))) unsigned char lds_raw[];
    LAS unsigned char* lds = (LAS unsigned char*)lds_raw;
    const int G = (int)gridDim.x, bx = (int)blockIdx.x, wv = __builtin_amdgcn_readfirstlane((int)threadIdx.x >> 6);
    volatile LAS unsigned* MISC = (volatile LAS unsigned*)(lds + MISC_OFF);
    if (threadIdx.x < 64) MISC[threadIdx.x] = 0u;
    __syncthreads();
    const int lo = a.ph_lo, hi = a.ph_hi; (void)lo; (void)hi;
    if (!MK_CUTS || hi - lo > 1) (void)xcd_barrier_post((unsigned*)(a.P.ws + WS_CTL) + CW_BAR, MISC + 8);
#if MK_CUTS
#define IN(k) (lo <= (k) && (k) < hi)
#else
#define IN(k) true
#endif
#define SEAM(k, kn) do { if (IN(k) && IN(kn)) { KARGS(apb_); XcdBarrier b_; b_.bar = (unsigned*)(apb_->P.ws + WS_CTL) + CW_BAR; b_.x = xb_xcc_id(); b_.st = MISC + 8; xcd_barrier(b_, wv); } } while (0)
#define THIN_IDS() const int tid_ = fresh_tid(wv), lane = tid_ & 63, gw = bx * 8 + (tid_ >> 6), ngw = G * 8
    if (IN(0)) for (int rep_ = 0; rep_ < REP_PRO; ++rep_) { KARGS(ap); Params P;
        P.x = ap->P.x; P.gla_w_in = ap->P.gla_w_in; P.gla_wgu = ap->P.gla_wgu; P.gla_gbias = ap->P.gla_gbias; P.gla_norm_g = ap->P.gla_norm_g; P.gla_w_out = ap->P.gla_w_out; P.dil_w_in = ap->P.dil_w_in; P.dil_w_out = ap->P.dil_w_out;
        P.ffn_w_up = ap->P.ffn_w_up; P.conv_w = ap->P.conv_w; P.conv_b = ap->P.conv_b; P.ffn_w_down = ap->P.ffn_w_down; P.ln_g = ap->P.ln_g; P.ln_b = ap->P.ln_b; P.out = ap->P.out; P.ws = ap->P.ws;
        prologue(P, lds, bx, G, wv); }
    SEAM(0, 1);
    for (int i = 0; i < DEPTH; ++i) {
        const int j = i >> 1, pb = 1 + 10 * i;
        if ((i & 1) == 0) {
            if (IN(pb)) for (int rep_ = 0; rep_ < REP_GIN; ++rep_) { KARGS(ap); unsigned char* ws = ap->P.ws;
                pg8::Gemm g{(const bf16*)ap->P.out, (const bf16*)(ws + WS_WGI) + (size_t)j * GLA_NPAD * DM, MTOK, GLA_NPAD, DM, DM, DM, 0};
                pg8::StaticOrder S; S.init(MTOK, GLA_NPAD, G, bx);
                pg8::EpiGlaIn E{(bf16*)(ws + WS_QK), (float*)(ws + WS_GLOW), (size_t)(WS_V - WS_QK) / 2};
                static_assert(WS_R - WS_V == WS_V - WS_QK, "q|k, v, r tensors equally spaced");
                pg8::gemm_phase<pg8::EpiGlaIn, pg8::StaticOrder, true, true>(lds, g, S, E, wv); }
            SEAM(pb, pb + 1);
            if (IN(pb + 1)) for (int rep_ = 0; rep_ < REP_PREP; ++rep_) { KARGS(ap); unsigned char* ws = ap->P.ws;
                gla::prep(lds, (const bf16*)(ws + WS_QK), (const bf16*)(ws + WS_V), (const float*)(ws + WS_GLOW), ap->P.gla_wgu + (size_t)j * GLA_RANK * GLA_DK, ap->P.gla_gbias + (size_t)j * GLA_DK, ws + WS_IMG, (bf16*)(ws + WS_VT), bx, G, wv); }
            SEAM(pb + 1, pb + 2);
            if (IN(pb + 2)) for (int rep_ = 0; rep_ < REP_REC; ++rep_) { KARGS(ap); unsigned char* ws = ap->P.ws;
                const int vcu = (G % 8 == 0) ? (bx % 8) * (G / 8) + bx / 8 : bx;
                gla::rec(lds, ws + WS_IMG, (const bf16*)(ws + WS_VT), (bf16*)(ws + WS_O), vcu, G, wv); }
            SEAM(pb + 2, pb + 3);
            if (IN(pb + 3)) for (int rep_ = REP_GN - 1; rep_ >= 0; --rep_) { KARGS(ap); unsigned char* ws = ap->P.ws; THIN_IDS();
                gatenorm_rows((const bf16*)(ws + WS_O), (bf16*)(ws + (rep_ ? WS_DUMMY : WS_O)), (const bf16*)(ws + WS_R), ap->P.gla_norm_g + (size_t)j * GLA_HV, gw, ngw, lane); }
            SEAM(pb + 3, pb + 4);
            if (IN(pb + 4)) for (int rep_ = REP_OUT - 1; rep_ >= 0; --rep_) { KARGS(ap); unsigned char* ws = ap->P.ws;
                pg8::Gemm g{(const bf16*)(ws + WS_O), (const bf16*)(ws + WS_WGO) + (size_t)j * DM * GLA_DV, MTOK, DM, GLA_DV, GLA_DV, GLA_DV, 0};
                pg8::StaticOrder S; S.init(MTOK, DM, G, bx);
                pg8::EpiRes E{ap->P.x, (short*)(ws + WS_YQ), (const float*)(ws + WS_STATS), ap->P.ln_g + (size_t)(2 * i - 1) * DM, ap->P.ln_b + (size_t)(2 * i - 1) * DM, ALPHA, i == 0 ? 0 : 1};
                pg8::gemm_phase<pg8::EpiRes, pg8::StaticOrder, true, true>(lds, g, S, E, wv); }
        } else {
            if (IN(pb)) for (int rep_ = 0; rep_ < REP_GIN; ++rep_) { KARGS(ap); unsigned char* ws = ap->P.ws;
                pg8::Gemm g{(const bf16*)ap->P.out, (const bf16*)(ws + WS_WDI) + (size_t)j * DIL_IN * DM, MTOK, DIL_IN, DM, DM, DM, 0};
                pg8::StaticOrder S; S.init(MTOK, DIL_IN, G, bx);
                pg8::EpiBf16Plain E{(bf16*)(ws + WS_PROJ), DIL_IN, 0};
                pg8::gemm_phase<pg8::EpiBf16Plain, pg8::StaticOrder, true, true>(lds, g, S, E, wv); }
            SEAM(pb, pb + 1);
            if (IN(pb + 1)) for (int rep_ = 0; rep_ < REP_SWA; ++rep_) { KARGS(ap); unsigned char* ws = ap->P.ws;
                swa::phase((char*)lds_raw, (const bf16*)(ws + WS_PROJ), (bf16*)(ws + WS_OG), (float*)(ws + WS_LSE), bx, G, wv); }
            SEAM(pb + 1, pb + 2);
            if (IN(pb + 2)) for (int rep_ = REP_COMB - 1; rep_ >= 0; --rep_) { KARGS(ap); unsigned char* ws = ap->P.ws; THIN_IDS();
                combine_rows((const bf16*)(ws + WS_OG), (bf16*)(ws + (rep_ ? WS_REG : WS_OG)), (const float*)(ws + WS_LSE), gw, ngw, lane); }
            SEAM(pb + 2, pb + 4);
            if (IN(pb + 4)) for (int rep_ = REP_OUT - 1; rep_ >= 0; --rep_) { KARGS(ap); unsigned char* ws = ap->P.ws;
                pg8::Gemm g{(const bf16*)(ws + WS_OG), (const bf16*)(ws + WS_WDO) + (size_t)j * DM * DIL_WIDTH, MTOK, DM, DIL_WIDTH, DIL_WIDTH, DIL_WIDTH, 0};
                pg8::StaticOrder S; S.init(MTOK, DM, G, bx);
                pg8::EpiRes E{nullptr, (short*)(ws + WS_YQ), (const float*)(ws + WS_STATS), ap->P.ln_g + (size_t)(2 * i - 1) * DM, ap->P.ln_b + (size_t)(2 * i - 1) * DM, ALPHA, 1};
                pg8::gemm_phase<pg8::EpiRes, pg8::StaticOrder, true, true>(lds, g, S, E, wv); }
        }
        SEAM(pb + 4, pb + 5);
        if (IN(pb + 5)) for (int rep_ = REP_LN - 1; rep_ >= 0; --rep_) { KARGS(ap); unsigned char* ws = ap->P.ws; THIN_IDS();
            ln_rows<false>((const short*)(ws + WS_YQ), nullptr, (bf16*)ap->P.out, (float*)(ws + WS_STATS), ap->P.ln_g + (size_t)(2 * i) * DM, ap->P.ln_b + (size_t)(2 * i) * DM, gw, ngw, lane); }
        SEAM(pb + 5, pb + 6);
        if (IN(pb + 6)) for (int rep_ = 0; rep_ < REP_UP; ++rep_) { KARGS(ap); unsigned char* ws = ap->P.ws;
            pg8::Gemm g{(const bf16*)ap->P.out, (const bf16*)(ws + WS_WUP) + (size_t)i * NUP * DM, MTOK, NUP, DM, DM, DM, 0};
            pg8::StaticOrder S; S.init(MTOK, NUP, G, bx);
            pg8::EpiFfnUp E{(bf16*)(ws + WS_ACT), (float*)(ws + WS_HALO), ap->P.conv_w + (size_t)i * 3 * NUP, ap->P.conv_b + (size_t)i * NUP};
            pg8::gemm_phase<pg8::EpiFfnUp, pg8::StaticOrder, true, true>(lds, g, S, E, wv); }
        SEAM(pb + 6, pb + 7);
        if (IN(pb + 7)) for (int rep_ = 0; rep_ < REP_FIX; ++rep_) { KARGS(ap); unsigned char* ws = ap->P.ws; const int tid_ = fresh_tid(wv);
            ffn_fixup((const float*)(ws + WS_HALO), (bf16*)(ws + WS_ACT), ap->P.conv_w + (size_t)i * 3 * NUP, ap->P.conv_b + (size_t)i * NUP, bx * 512 + tid_, G * 512); }
        SEAM(pb + 7, pb + 8);
        if (IN(pb + 8)) for (int rep_ = REP_DOWN - 1; rep_ >= 0; --rep_) { KARGS(ap); unsigned char* ws = ap->P.ws;
            pg8::Gemm g{(const bf16*)(ws + WS_ACT), (const bf16*)(ws + WS_WDN) + (size_t)i * DM * DFF, MTOK, DM, DFF, DFF, DFF, 0};
            pg8::StaticOrder S; S.init(MTOK, DM, G, bx);
            pg8::EpiRes E{nullptr, (short*)(ws + WS_YQ), (const float*)(ws + WS_STATS), ap->P.ln_g + (size_t)(2 * i) * DM, ap->P.ln_b + (size_t)(2 * i) * DM, ALPHA, 1};
            pg8::gemm_phase<pg8::EpiRes, pg8::StaticOrder, true, true>(lds, g, S, E, wv); }
        SEAM(pb + 8, pb + 9);
        if (IN(pb + 9)) for (int rep_ = REP_LN - 1; rep_ >= 0; --rep_) { KARGS(ap); unsigned char* ws = ap->P.ws; THIN_IDS();
            if (i == DEPTH - 1) ln_rows<true>((const short*)(ws + WS_YQ), ap->P.out, nullptr, nullptr, ap->P.ln_g + (size_t)(2 * i + 1) * DM, ap->P.ln_b + (size_t)(2 * i + 1) * DM, gw, ngw, lane);
            else ln_rows<false>((const short*)(ws + WS_YQ), nullptr, (bf16*)ap->P.out, (float*)(ws + WS_STATS), ap->P.ln_g + (size_t)(2 * i + 1) * DM, ap->P.ln_b + (size_t)(2 * i + 1) * DM, gw, ngw, lane); }
        SEAM(pb + 9, pb + 10);
    }
#undef IN
#undef SEAM
#undef THIN_IDS
}

extern "C" void kernel_launch(void* const* d_in, const int* in_sizes, int n_in, void* d_out, int out_size, void* d_ws, size_t ws_size, hipStream_t stream) {
    static int grid = 0;
    if (grid == 0) {
        if (n_in != 14 || out_size != MTOK * DM || ws_size < WS_END) { fprintf(stderr, "kernel_launch: unexpected shapes (n_in %d out %d ws %zu need %zu)\n", n_in, out_size, ws_size, (size_t)WS_END); grid = -1; return; }
        int dev = 0, cus = 0, per_cu = 0;
        if (hipGetDevice(&dev) != hipSuccess || hipDeviceGetAttribute(&cus, hipDeviceAttributeMultiprocessorCount, dev) != hipSuccess) { grid = -1; return; }
        if (hipFuncSetAttribute((const void*)mega, hipFuncAttributeMaxDynamicSharedMemorySize, LDS_BYTES) != hipSuccess) { fprintf(stderr, "kernel_launch: hipFuncSetAttribute failed\n"); grid = -1; return; }
        if (hipOccupancyMaxActiveBlocksPerMultiprocessor(&per_cu, (const void*)mega, 512, LDS_BYTES) != hipSuccess || per_cu < 1) fprintf(stderr, "kernel_launch: occupancy query says %d blocks per CU\n", per_cu);
        (void)hipGetLastError();
        grid = cus;
    }
    if (grid < 0) return;
    (void)hipMemsetAsync((char*)d_ws + WS_CTL, 0, CTL_ZERO_BYTES, stream);
    Args a; memset(&a, 0, sizeof a);
    Params& P = a.P;
    P.x = (const float*)d_in[0]; P.gla_w_in = (const float*)d_in[1]; P.gla_wgu = (const float*)d_in[2]; P.gla_gbias = (const float*)d_in[3]; P.gla_norm_g = (const float*)d_in[4]; P.gla_w_out = (const float*)d_in[5];
    P.dil_w_in = (const float*)d_in[6]; P.dil_w_out = (const float*)d_in[7]; P.ffn_w_up = (const float*)d_in[8]; P.conv_w = (const float*)d_in[9]; P.conv_b = (const float*)d_in[10]; P.ffn_w_down = (const float*)d_in[11];
    P.ln_g = (const float*)d_in[12]; P.ln_b = (const float*)d_in[13]; P.out = (float*)d_out; P.ws = (unsigned char*)d_ws;
#if MK_CUTS
    for (int k = 0; k < N_PHASES; ++k) { a.ph_lo = k; a.ph_hi = k + 1; hipLaunchKernelGGL(mega, dim3(grid), dim3(512), LDS_BYTES, stream, a); }
#else
    a.ph_lo = 0; a.ph_hi = N_PHASES;
    hipLaunchKernelGGL(mega, dim3(grid), dim3(512), LDS_BYTES, stream, a);
#endif
}
```
